# Optimizing an MI355X kernel written in HIP

```python
import jax, jax.numpy as jnp
from jax import lax
import numpy as np

D_MODEL = 1024
BATCH = 2
SEQ = 16384
DEPTH = 1

HEAD_DIM = 64
ATTN_SCALE = HEAD_DIM ** -0.5
DIL_PAIRS = ((128, 1), (512, 4), (2048, 16))
N_DIL_GROUPS = len(DIL_PAIRS)
DIL_HEADS = 8
DIL_QBLK = 128
MOBA_HEADS = 8
MOBA_BLOCK = 256
MOBA_TOPK = 3
MOBA_QCHUNK = 64
MEM_TOKENS = 256
MEM_HEADS = 4
N_BRANCHES = 3
EPS = 1e-6
NEG_INF = -1e30

D_A = DIL_HEADS * HEAD_DIM
D_B = MOBA_HEADS * HEAD_DIM
D_M = MEM_HEADS * HEAD_DIM
IN_SIZES = [D_A] * (3 * N_DIL_GROUPS) + [D_A] + [D_B] * 4 + [D_M] * 2 + [N_BRANCHES * D_MODEL]
D_IN = int(sum(IN_SIZES))
IN_SPLIT_POINTS = tuple(int(v) for v in np.cumsum(IN_SIZES)[:-1])

kernel_name = "hybrid_dilated_moba_memory_gated_block"


def rmsnorm(x, w):
    xf = x.astype(jnp.float32)
    y = xf * lax.rsqrt(jnp.mean(xf * xf, axis=-1, keepdims=True) + EPS)
    return (y * w.astype(jnp.float32)).astype(x.dtype)


def alibi_slopes(n):
    return jnp.asarray(2.0 ** (-8.0 * np.arange(1, n + 1) / n), dtype=jnp.float32)


def dilated_window_group(q, k, v, slopes, window, dilation):
    B, S, H, Dh = q.shape
    n = S // dilation
    nb = n // DIL_QBLK
    span = window // dilation

    def to_blocks(t):
        t = t.reshape(B, n, dilation, H, Dh).transpose(0, 2, 3, 1, 4)
        return t.reshape(B, dilation, H, nb, DIL_QBLK, Dh)

    def band(t):
        prev = jnp.pad(t[:, :, :, :-1], ((0, 0), (0, 0), (0, 0), (1, 0), (0, 0), (0, 0)))
        return jnp.concatenate([prev, t], axis=4)

    qb = to_blocks(q)
    kb = band(to_blocks(k))
    vb = band(to_blocks(v))
    s = jnp.einsum("brhnqd,brhnkd->brhnqk", qb, kb, preferred_element_type=jnp.float32) * ATTN_SCALE
    a = jnp.arange(DIL_QBLK)[:, None]
    c = jnp.arange(2 * DIL_QBLK)[None, :]
    j = a + DIL_QBLK - c
    blk = jnp.arange(nb)[:, None, None]
    valid = (j >= 0) & (j <= span) & ((blk > 0) | (c >= DIL_QBLK))
    bias = -slopes[:, None, None] * (j * dilation).astype(jnp.float32)
    s = jnp.where(valid[None, None, None], s + bias[None, None, :, None], NEG_INF)
    m = jnp.max(s, axis=-1, keepdims=True)
    e = jnp.exp(s - m)
    den = jnp.sum(e, axis=-1)
    o = jnp.einsum("brhnqk,brhnkd->brhnqd", e.astype(v.dtype), vb,
                   preferred_element_type=jnp.float32) / den[..., None]
    lse = m[..., 0] + jnp.log(den)
    o = o.reshape(B, dilation, H, n, Dh).transpose(0, 3, 1, 2, 4).reshape(B, S, H, Dh)
    lse = lse.reshape(B, dilation, H, n).transpose(0, 3, 1, 2).reshape(B, S, H)
    return o, lse


def dilated_mixture(groups, slopes):
    B, S, H, Dh = groups[0][0].shape
    align = max(d for _, d in DIL_PAIRS) * DIL_QBLK
    S_pad = -(-S // align) * align

    def pad(t):
        return jnp.pad(t, ((0, 0), (0, S_pad - S), (0, 0), (0, 0)))

    outs, lses = [], []
    for (window, dilation), (q, k, v) in zip(DIL_PAIRS, groups):
        o, l = dilated_window_group(pad(q), pad(k), pad(v), slopes, window, dilation)
        outs.append(o[:, :S])
        lses.append(l[:, :S])
    w = jax.nn.softmax(jnp.stack(lses, 0), axis=0)
    o = jnp.einsum("gbsh,gbshd->bshd", w, jnp.stack(outs, 0))
    return o.astype(groups[0][0].dtype)


def moba_attention(q, k, v, slopes):
    B, S, H, Dh = q.shape
    S_pad = -(-S // MOBA_BLOCK) * MOBA_BLOCK
    padw = ((0, 0), (0, S_pad - S), (0, 0), (0, 0))
    q = jnp.pad(q, padw).transpose(0, 2, 1, 3)
    k = jnp.pad(k, padw).transpose(0, 2, 1, 3)
    v = jnp.pad(v, padw).transpose(0, 2, 1, 3)
    nblk = S_pad // MOBA_BLOCK
    kblk = k.reshape(B, H, nblk, MOBA_BLOCK, Dh)
    vblk = v.reshape(B, H, nblk, MOBA_BLOCK, Dh)
    kmean = jnp.mean(kblk.astype(jnp.float32), axis=3)
    gate = jnp.einsum("bhsd,bhnd->bhsn", q.astype(jnp.float32), kmean)
    qblk_id = jnp.arange(S_pad) // MOBA_BLOCK
    past = jnp.arange(nblk)[None, :] < qblk_id[:, None]
    gate = jnp.where(past[None, None], gate, NEG_INF)
    topk = min(MOBA_TOPK, nblk)
    _, sel = lax.top_k(gate, topk)
    sel_valid = jnp.arange(topk)[None, :] < qblk_id[:, None]
    bi = jnp.arange(B)[:, None, None, None]
    hi = jnp.arange(H)[None, :, None, None]
    koff = jnp.arange(MOBA_BLOCK)

    def chunk(ci):
        start = ci * MOBA_QCHUNK
        qc = lax.dynamic_slice_in_dim(q, start, MOBA_QCHUNK, axis=2)
        selc = lax.dynamic_slice_in_dim(sel, start, MOBA_QCHUNK, axis=2)
        validc = lax.dynamic_slice_in_dim(sel_valid, start, MOBA_QCHUNK, axis=0)
        k_sel = kblk[bi, hi, selc]
        v_sel = vblk[bi, hi, selc]
        own = start // MOBA_BLOCK
        k_own = lax.dynamic_index_in_dim(kblk, own, axis=2, keepdims=False)
        v_own = lax.dynamic_index_in_dim(vblk, own, axis=2, keepdims=False)
        t = start + jnp.arange(MOBA_QCHUNK)
        s_sel = jnp.einsum("bhqd,bhqnkd->bhqnk", qc, k_sel,
                           preferred_element_type=jnp.float32) * ATTN_SCALE
        pos_sel = selc[..., None] * MOBA_BLOCK + koff
        dist_sel = (t[None, None, :, None, None] - pos_sel).astype(jnp.float32)
        s_sel = s_sel - slopes[None, :, None, None, None] * dist_sel
        s_sel = jnp.where(validc[None, None, :, :, None], s_sel, NEG_INF)
        s_own = jnp.einsum("bhqd,bhkd->bhqk", qc, k_own,
                           preferred_element_type=jnp.float32) * ATTN_SCALE
        dist_own = t[:, None] - (own * MOBA_BLOCK + koff)[None, :]
        s_own = jnp.where(dist_own[None, None] >= 0,
                          s_own - slopes[None, :, None, None] * dist_own.astype(jnp.float32)[None, None],
                          NEG_INF)
        s_all = jnp.concatenate([s_sel.reshape(B, H, MOBA_QCHUNK, topk * MOBA_BLOCK), s_own], axis=-1)
        p = jax.nn.softmax(s_all, axis=-1).astype(v.dtype)
        p_sel = p[..., : topk * MOBA_BLOCK].reshape(B, H, MOBA_QCHUNK, topk, MOBA_BLOCK)
        p_own = p[..., topk * MOBA_BLOCK:]
        o = jnp.einsum("bhqnk,bhqnkd->bhqd", p_sel, v_sel, preferred_element_type=jnp.float32)
        o = o + jnp.einsum("bhqk,bhkd->bhqd", p_own, v_own, preferred_element_type=jnp.float32)
        return o

    n_chunks = S_pad // MOBA_QCHUNK
    o = lax.map(chunk, jnp.arange(n_chunks))
    o = o.transpose(1, 2, 0, 3, 4).reshape(B, H, S_pad, Dh).transpose(0, 2, 1, 3)[:, :S]
    return o.astype(q.dtype)


def memory_cross_attention(q, k, v):
    s = jnp.einsum("bshd,bmhd->bhsm", q, k, preferred_element_type=jnp.float32) * ATTN_SCALE
    p = jax.nn.softmax(s, axis=-1).astype(v.dtype)
    return jnp.einsum("bhsm,bmhd->bshd", p, v)


def setup_inputs(seed: int = 0) -> dict:
    key = jax.random.key(seed)
    ks = jax.random.split(key, 12)
    f32 = jnp.float32
    x = jax.random.normal(ks[0], (BATCH, SEQ, D_MODEL), f32)
    mem = jax.random.normal(ks[1], (BATCH, MEM_TOKENS, D_MODEL), f32)
    norm_w = 1.0 + 0.02 * jax.random.normal(ks[2], (DEPTH, D_MODEL), f32)
    mem_norm_w = 1.0 + 0.02 * jax.random.normal(ks[3], (DEPTH, D_MODEL), f32)
    w_in = jax.random.normal(ks[4], (DEPTH, D_MODEL, D_IN), f32) * D_MODEL ** -0.5
    b_merge = 0.1 * jax.random.normal(ks[5], (DEPTH, N_BRANCHES * D_MODEL), f32)
    w_mem_kv = jax.random.normal(ks[6], (DEPTH, D_MODEL, 2 * D_M), f32) * D_MODEL ** -0.5
    w_branch_a = jax.random.normal(ks[7], (DEPTH, D_A, D_MODEL), f32) * D_A ** -0.5
    w_branch_b = jax.random.normal(ks[8], (DEPTH, D_B, D_MODEL), f32) * D_B ** -0.5
    w_branch_m = jax.random.normal(ks[9], (DEPTH, D_M, D_MODEL), f32) * D_M ** -0.5
    w_out = jax.random.normal(ks[10], (DEPTH, D_MODEL, D_MODEL), f32) * D_MODEL ** -0.5
    final_norm_w = 1.0 + 0.02 * jax.random.normal(ks[11], (D_MODEL,), f32)
    return {"x": x, "mem": mem, "norm_w": norm_w, "mem_norm_w": mem_norm_w, "w_in": w_in,
            "b_merge": b_merge, "w_mem_kv": w_mem_kv, "w_branch_a": w_branch_a,
            "w_branch_b": w_branch_b, "w_branch_m": w_branch_m, "w_out": w_out,
            "final_norm_w": final_norm_w}


def reference(x, mem, norm_w, mem_norm_w, w_in, b_merge, w_mem_kv, w_branch_a, w_branch_b,
              w_branch_m, w_out, final_norm_w):
    B, S, _ = x.shape
    slopes = alibi_slopes(DIL_HEADS + MOBA_HEADS)
    slopes_a = slopes[0::2]
    slopes_b = slopes[1::2]

    def heads(t):
        return t.reshape(t.shape[0], t.shape[1], -1, HEAD_DIM)

    for l in range(DEPTH):
        h = rmsnorm(x, norm_w[l])
        proj = h @ w_in[l]
        pieces = jnp.split(proj, IN_SPLIT_POINTS, axis=-1)
        a_qkv = pieces[: 3 * N_DIL_GROUPS]
        a_gate = pieces[3 * N_DIL_GROUPS]
        b_q, b_k, b_v, b_gate = pieces[3 * N_DIL_GROUPS + 1: 3 * N_DIL_GROUPS + 5]
        m_q, m_gate = pieces[3 * N_DIL_GROUPS + 5: 3 * N_DIL_GROUPS + 7]
        merge_logits = pieces[3 * N_DIL_GROUPS + 7]

        groups = [(heads(a_qkv[3 * g]), heads(a_qkv[3 * g + 1]), heads(a_qkv[3 * g + 2]))
                  for g in range(N_DIL_GROUPS)]
        o_a = dilated_mixture(groups, slopes_a).reshape(B, S, D_A)
        o_b = moba_attention(heads(b_q), heads(b_k), heads(b_v), slopes_b).reshape(B, S, D_B)
        kv = rmsnorm(mem, mem_norm_w[l]) @ w_mem_kv[l]
        m_k, m_v = jnp.split(kv, 2, axis=-1)
        o_m = memory_cross_attention(heads(m_q), heads(m_k), heads(m_v)).reshape(B, S, D_M)

        p_a = (o_a * jax.nn.silu(a_gate)) @ w_branch_a[l]
        p_b = (o_b * jax.nn.silu(b_gate)) @ w_branch_b[l]
        p_m = (o_m * jax.nn.silu(m_gate)) @ w_branch_m[l]
        g_a, g_b, g_m = jnp.split(jax.nn.sigmoid(merge_logits + b_merge[l]), N_BRANCHES, axis=-1)
        merged = g_a * p_a + g_b * p_b + g_m * p_m
        x = x + merged @ w_out[l]
    return rmsnorm(x, final_norm_w)
```

```cpp
#include <hip/hip_runtime.h>
#include <stdint.h>
#include <stdio.h>

typedef unsigned short bf16_t;
typedef short bf16x8 __attribute__((ext_vector_type(8)));
typedef float f32x16 __attribute__((ext_vector_type(16)));
typedef float f32x4 __attribute__((ext_vector_type(4)));
typedef unsigned u32x4 __attribute__((ext_vector_type(4)));
typedef unsigned u32x2 __attribute__((ext_vector_type(2)));

constexpr int NB = 2, S = 16384, D = 1024, M = NB * S;
constexpr int DIN = 10752;
constexpr float EPS = 1e-6f;
constexpr float LOG2E = 1.4426950408889634f;
constexpr float LN2 = 0.6931471805599453f;
constexpr float C2 = 0.125f * LOG2E;

constexpr size_t MiB = 1u << 20;
constexpr size_t WS_CTL = 0;
constexpr size_t WS_KMEAN = 2 * MiB;
constexpr size_t WS_KM = 3 * MiB;
constexpr size_t WS_VM = 3 * MiB + 512 * 1024;
constexpr size_t WS_W = 12 * MiB;
constexpr size_t WS_WIN = WS_W;
constexpr size_t WS_WA = WS_WIN + (size_t)DIN * 1024 * 2;
constexpr size_t WS_WB = WS_WA + (size_t)1024 * 512 * 2;
constexpr size_t WS_WM = WS_WB + (size_t)1024 * 512 * 2;
constexpr size_t WS_WO = WS_WM + (size_t)1024 * 256 * 2;
constexpr size_t WS_XN = 40 * MiB;
constexpr size_t WS_MQ = 104 * MiB;
constexpr size_t WS_MG = 120 * MiB;
constexpr size_t WS_LIST = 136 * MiB;
constexpr size_t WS_R1 = 168 * MiB;
constexpr size_t SLOT = 32 * MiB;
constexpr size_t WS_END = WS_R1 + 10 * SLOT;
__host__ __device__ constexpr int slot_q(int g) { return g; }
__host__ __device__ constexpr int slot_k(int g) { return 3 + 2 * g; }
__host__ __device__ constexpr int slot_v(int g) { return 4 + 2 * g; }
constexpr int SLOT_AG = 9;

__device__ __forceinline__ float bf2f(bf16_t v) { return __uint_as_float(((unsigned)v) << 16); }
__device__ __forceinline__ bf16_t f2bf(float f) { unsigned u = __float_as_uint(f); return (bf16_t)((u + 0x7fffu + ((u >> 16) & 1u)) >> 16); }
__device__ __forceinline__ unsigned pk2(float lo, float hi) { return (unsigned)f2bf(lo) | ((unsigned)f2bf(hi) << 16); }
__device__ __forceinline__ float wave_sum(float v) {
#pragma unroll
    for (int o = 1; o < 64; o <<= 1) v += __shfl_xor(v, o);
    return v;
}
__device__ __forceinline__ float silu_f(float v) { return v / (1.f + __expf(-v)); }
__device__ __forceinline__ float sigmoid_f(float v) { return 1.f / (1.f + __expf(-v)); }

__global__ void k_transpose_w(const float* __restrict__ W, int K, int N, bf16_t* __restrict__ WT) {
    __shared__ float tile[32][33];
    const int n0 = blockIdx.x * 32, k0 = blockIdx.y * 32, tx = threadIdx.x & 31, ty = threadIdx.x >> 5;
    for (int i = ty; i < 32; i += 8) tile[i][tx] = W[(size_t)(k0 + i) * N + n0 + tx];
    __syncthreads();
    for (int i = ty; i < 32; i += 8) WT[(size_t)(n0 + i) * K + k0 + tx] = f2bf(tile[tx][i]);
}
__global__ void k_rmsnorm_bf16(const float* __restrict__ x, const float* __restrict__ w, bf16_t* __restrict__ out, int rows) {
    const int lane = threadIdx.x & 63, row = blockIdx.x * (blockDim.x >> 6) + (threadIdx.x >> 6);
    if (row >= rows) return;
    const f32x4* xr = (const f32x4*)(x + (size_t)row * D) + lane;
    f32x4 v[4]; float s = 0.f;
#pragma unroll
    for (int j = 0; j < 4; ++j) { v[j] = xr[64 * j]; s += (v[j].x * v[j].x + v[j].y * v[j].y) + (v[j].z * v[j].z + v[j].w * v[j].w); }
    const float rs = 1.0f / sqrtf(wave_sum(s) * (1.f / D) + EPS);
    unsigned long long* o8 = (unsigned long long*)(out + (size_t)row * D) + lane;
#pragma unroll
    for (int j = 0; j < 4; ++j) { const f32x4 ww = ((const f32x4*)w)[lane + 64 * j];
        o8[64 * j] = (unsigned long long)pk2(v[j].x * rs * ww.x, v[j].y * rs * ww.y) | ((unsigned long long)pk2(v[j].z * rs * ww.z, v[j].w * rs * ww.w) << 32); }
}
__global__ void k_memkv(const float* __restrict__ mem, const float* __restrict__ mw, const float* __restrict__ Wkv, bf16_t* __restrict__ KM, bf16_t* __restrict__ VM) {
    const int idx = blockIdx.x * blockDim.x + threadIdx.x;
    const int r = idx >> 9, n = idx & 511;
    const float* mr = mem + (size_t)r * D;
    float ss = 0.f, acc = 0.f;
    for (int k = 0; k < D; ++k) { const float a = mr[k]; ss += a * a; acc += a * mw[k] * Wkv[(size_t)k * 512 + n]; }
    const float rs = 1.0f / sqrtf(ss * (1.f / D) + EPS);
    const float v = acc * rs;
    if (n < 256) KM[(size_t)r * 256 + n] = f2bf(v); else VM[(size_t)r * 256 + (n - 256)] = f2bf(v);
}

struct GemmEpi {
    int mode;
    float scale;
    bf16_t* dst; int ldc;
    const float* bias;
    const bf16_t* gate; int ldg; int first;
    const float* xres; float* dstf;
};
__device__ __forceinline__ int crow(int r, int hi) { return (r & 3) + 8 * (r >> 2) + 4 * hi; }

__global__ void __launch_bounds__(256) k_gemm(const bf16_t* __restrict__ A, int lda, const bf16_t* __restrict__ Bt, int ldb, int K, GemmEpi E) {
    const int lane = threadIdx.x & 63, wid = threadIdx.x >> 6, r32 = lane & 31, hi = lane >> 5;
    const int tok0 = blockIdx.y * 128 + (wid >> 1) * 64, f0 = blockIdx.x * 128 + (wid & 1) * 64;
    f32x16 acc[2][2];
#pragma unroll
    for (int i = 0; i < 2; ++i)
#pragma unroll
        for (int j = 0; j < 2; ++j)
#pragma unroll
            for (int r = 0; r < 16; ++r) acc[i][j][r] = 0.f;
    const bf16_t* ap0 = A + (size_t)(tok0 + r32) * lda + 8 * hi;
    const bf16_t* ap1 = ap0 + (size_t)32 * lda;
    const bf16_t* bp0 = Bt + (size_t)(f0 + r32) * ldb + 8 * hi;
    const bf16_t* bp1 = bp0 + (size_t)32 * ldb;
    for (int k0 = 0; k0 < K; k0 += 16) {
        const bf16x8 a0 = *(const bf16x8*)(ap0 + k0), a1 = *(const bf16x8*)(ap1 + k0);
        const bf16x8 b0 = *(const bf16x8*)(bp0 + k0), b1 = *(const bf16x8*)(bp1 + k0);
        acc[0][0] = __builtin_amdgcn_mfma_f32_32x32x16_bf16(b0, a0, acc[0][0], 0, 0, 0);
        acc[0][1] = __builtin_amdgcn_mfma_f32_32x32x16_bf16(b1, a0, acc[0][1], 0, 0, 0);
        acc[1][0] = __builtin_amdgcn_mfma_f32_32x32x16_bf16(b0, a1, acc[1][0], 0, 0, 0);
        acc[1][1] = __builtin_amdgcn_mfma_f32_32x32x16_bf16(b1, a1, acc[1][1], 0, 0, 0);
    }
#pragma unroll
    for (int ti = 0; ti < 2; ++ti)
#pragma unroll
        for (int fj = 0; fj < 2; ++fj)
#pragma unroll
            for (int g = 0; g < 4; ++g) {
                const int tok = tok0 + 32 * ti + r32, f = f0 + 32 * fj + 8 * g + 4 * hi;
                float v[4];
#pragma unroll
                for (int j = 0; j < 4; ++j) v[j] = acc[ti][fj][4 * g + j];
                if (E.mode == 4) {
                    const f32x4 xr = *(const f32x4*)(E.xres + (size_t)tok * E.ldc + f);
                    *(f32x4*)(E.dstf + (size_t)tok * E.ldc + f) = (f32x4){xr.x + v[0], xr.y + v[1], xr.z + v[2], xr.w + v[3]};
                } else {
                    if (E.mode == 0) { for (int j = 0; j < 4; ++j) v[j] *= E.scale; }
                    else if (E.mode == 1) { for (int j = 0; j < 4; ++j) v[j] = silu_f(v[j]); }
                    else if (E.mode == 2) { for (int j = 0; j < 4; ++j) v[j] = sigmoid_f(v[j] + E.bias[f + j]); }
                    else if (E.mode == 3) {
                        const u32x2 gw = *(const u32x2*)(E.gate + (size_t)tok * E.ldg + f);
                        float gg[4] = {bf2f((bf16_t)(gw.x & 0xffff)), bf2f((bf16_t)(gw.x >> 16)), bf2f((bf16_t)(gw.y & 0xffff)), bf2f((bf16_t)(gw.y >> 16))};
                        float pv[4] = {0.f, 0.f, 0.f, 0.f};
                        if (!E.first) { const u32x2 pw = *(const u32x2*)(E.dst + (size_t)tok * E.ldc + f);
                            pv[0] = bf2f((bf16_t)(pw.x & 0xffff)); pv[1] = bf2f((bf16_t)(pw.x >> 16)); pv[2] = bf2f((bf16_t)(pw.y & 0xffff)); pv[3] = bf2f((bf16_t)(pw.y >> 16)); }
                        for (int j = 0; j < 4; ++j) v[j] = pv[j] + gg[j] * v[j];
                    }
                    u32x2 o; o.x = pk2(v[0], v[1]); o.y = pk2(v[2], v[3]);
                    *(u32x2*)(E.dst + (size_t)tok * E.ldc + f) = o;
                }
            }
}

__device__ __forceinline__ void load64(const bf16_t* p, float* f) {
#pragma unroll
    for (int c = 0; c < 8; ++c) { const u32x4 w = *(const u32x4*)(p + 8 * c);
        f[8 * c + 0] = __uint_as_float(w.x << 16); f[8 * c + 1] = __uint_as_float(w.x & 0xffff0000u);
        f[8 * c + 2] = __uint_as_float(w.y << 16); f[8 * c + 3] = __uint_as_float(w.y & 0xffff0000u);
        f[8 * c + 4] = __uint_as_float(w.z << 16); f[8 * c + 5] = __uint_as_float(w.z & 0xffff0000u);
        f[8 * c + 6] = __uint_as_float(w.w << 16); f[8 * c + 7] = __uint_as_float(w.w & 0xffff0000u); }
}
#define ATT_STEP(krow, vrow, bias2) do { \
    float kk_[64]; load64((krow), kk_); float s_ = 0.f; \
    _Pragma("unroll") for (int d_ = 0; d_ < 64; ++d_) s_ += q[d_] * kk_[d_]; \
    s_ += (bias2); \
    const float mn_ = fmaxf(mrun, s_), f_ = exp2f(mrun - mn_), p_ = exp2f(s_ - mn_); \
    float vv_[64]; load64((vrow), vv_); \
    lrun = lrun * f_ + p_; mrun = mn_; \
    _Pragma("unroll") for (int d_ = 0; d_ < 64; ++d_) o[d_] = o[d_] * f_ + p_ * vv_[d_]; } while (0)

__device__ __forceinline__ void store_gated(bf16_t* gp, const float* o, float inv) {
#pragma unroll
    for (int c = 0; c < 8; ++c) { const u32x4 w = *(const u32x4*)(gp + 8 * c); u32x4 r;
        r.x = pk2(o[8 * c + 0] * inv * __uint_as_float(w.x << 16), o[8 * c + 1] * inv * __uint_as_float(w.x & 0xffff0000u));
        r.y = pk2(o[8 * c + 2] * inv * __uint_as_float(w.y << 16), o[8 * c + 3] * inv * __uint_as_float(w.y & 0xffff0000u));
        r.z = pk2(o[8 * c + 4] * inv * __uint_as_float(w.z << 16), o[8 * c + 5] * inv * __uint_as_float(w.z & 0xffff0000u));
        r.w = pk2(o[8 * c + 6] * inv * __uint_as_float(w.w << 16), o[8 * c + 7] * inv * __uint_as_float(w.w & 0xffff0000u));
        *(u32x4*)(gp + 8 * c) = r; }
}

__global__ void __launch_bounds__(64) k_mixA_gold(bf16_t* __restrict__ R1) {
    const int idx = blockIdx.x * blockDim.x + threadIdx.x;
    const int h = idx & 7, m = idx >> 3, b = m / S, t = m % S;
    const float slope2 = exp2f(-(float)h - 0.5f) * LOG2E;
    float o[64]; float mrun = -1e30f, lrun = 0.f;
#pragma unroll
    for (int d = 0; d < 64; ++d) o[d] = 0.f;
    for (int g = 0; g < 3; ++g) {
        const int dil = (g == 0) ? 1 : (g == 1) ? 4 : 16;
        const bf16_t* Q = (const bf16_t*)((const char*)R1 + (size_t)slot_q(g) * SLOT);
        const bf16_t* Kp = (const bf16_t*)((const char*)R1 + (size_t)slot_k(g) * SLOT);
        const bf16_t* Vp = (const bf16_t*)((const char*)R1 + (size_t)slot_v(g) * SLOT);
        float q[64]; load64(Q + (size_t)m * 512 + h * 64, q);
        for (int j = 0; j <= 128; ++j) {
            const int tk = t - j * dil; if (tk < 0) break;
            const size_t kr = ((size_t)b * S + tk) * 512 + h * 64;
            ATT_STEP(Kp + kr, Vp + kr, -slope2 * (float)(j * dil));
        }
    }
    bf16_t* AG = (bf16_t*)((char*)R1 + (size_t)SLOT_AG * SLOT);
    store_gated(AG + (size_t)m * 512 + h * 64, o, 1.f / lrun);
}

__global__ void k_kmean_gold(const bf16_t* __restrict__ BK, float* __restrict__ kmean) {
    const int idx = blockIdx.x * blockDim.x + threadIdx.x;
    const int d = idx & 63, n = (idx >> 6) & 63, bh = idx >> 12, b = bh >> 3, h = bh & 7;
    float s = 0.f;
    for (int r = 0; r < 256; ++r) s += bf2f(BK[((size_t)b * S + n * 256 + r) * 512 + h * 64 + d]);
    kmean[idx] = s * (1.f / 256.f);
}

__global__ void __launch_bounds__(64) k_moba_gold(const bf16_t* __restrict__ BQ, const bf16_t* __restrict__ BK, const bf16_t* __restrict__ BV, bf16_t* __restrict__ BG, const float* __restrict__ kmean) {
    const int idx = blockIdx.x * blockDim.x + threadIdx.x;
    const int h = idx & 7, m = idx >> 3, b = m / S, t = m % S, qb = t >> 8;
    const float slope2 = exp2f(-(float)(h + 1)) * LOG2E;
    float q[64]; load64(BQ + (size_t)m * 512 + h * 64, q);
    float bv0 = -INFINITY, bv1 = -INFINITY, bv2 = -INFINITY; int bi0 = -1, bi1 = -1, bi2 = -1;
    const float* km = kmean + (size_t)(b * 8 + h) * 64 * 64;
    for (int n = 0; n < qb; ++n) {
        float s = 0.f;
#pragma unroll
        for (int d = 0; d < 64; ++d) s += q[d] * km[n * 64 + d];
        if (s > bv0) { bv2 = bv1; bi2 = bi1; bv1 = bv0; bi1 = bi0; bv0 = s; bi0 = n; }
        else if (s > bv1) { bv2 = bv1; bi2 = bi1; bv1 = s; bi1 = n; }
        else if (s > bv2) { bv2 = s; bi2 = n; }
    }
    float o[64]; float mrun = -1e30f, lrun = 0.f;
#pragma unroll
    for (int d = 0; d < 64; ++d) o[d] = 0.f;
    for (int j = 0; j < 4; ++j) {
        const int blk = (j == 0) ? bi0 : (j == 1) ? bi1 : (j == 2) ? bi2 : qb;
        if (blk < 0) continue;
        const int p0 = blk * 256;
        for (int kk = 0; kk < 256; ++kk) {
            const int pos = p0 + kk; if (pos > t) break;
            const size_t kr = ((size_t)b * S + pos) * 512 + h * 64;
            ATT_STEP(BK + kr, BV + kr, -slope2 * (float)(t - pos));
        }
    }
    store_gated(BG + (size_t)m * 512 + h * 64, o, 1.f / lrun);
}

__global__ void __launch_bounds__(64) k_mem_gold(const bf16_t* __restrict__ MQ, const bf16_t* __restrict__ KM, const bf16_t* __restrict__ VM, bf16_t* __restrict__ MG) {
    const int idx = blockIdx.x * blockDim.x + threadIdx.x;
    const int h = idx & 3, m = idx >> 2, b = m / S;
    float q[64]; load64(MQ + (size_t)m * 256 + h * 64, q);
    float o[64]; float mrun = -1e30f, lrun = 0.f;
#pragma unroll
    for (int d = 0; d < 64; ++d) o[d] = 0.f;
    for (int j = 0; j < 256; ++j) {
        const size_t kr = ((size_t)b * 256 + j) * 256 + h * 64;
        ATT_STEP(KM + kr, VM + kr, 0.f);
    }
    store_gated(MG + (size_t)m * 256 + h * 64, o, 1.f / lrun);
}

__global__ void k_final_norm(float* __restrict__ out, const float* __restrict__ w, int rows) {
    const int lane = threadIdx.x & 63, row = blockIdx.x * (blockDim.x >> 6) + (threadIdx.x >> 6);
    if (row >= rows) return;
    f32x4* xr = (f32x4*)(out + (size_t)row * D) + lane;
    f32x4 v[4]; float s = 0.f;
#pragma unroll
    for (int j = 0; j < 4; ++j) { v[j] = xr[64 * j]; s += (v[j].x * v[j].x + v[j].y * v[j].y) + (v[j].z * v[j].z + v[j].w * v[j].w); }
    const float rs = 1.0f / sqrtf(wave_sum(s) * (1.f / D) + EPS);
#pragma unroll
    for (int j = 0; j < 4; ++j) { const f32x4 ww = ((const f32x4*)w)[lane + 64 * j]; xr[64 * j] = (f32x4){v[j].x * rs * ww.x, v[j].y * rs * ww.y, v[j].z * rs * ww.z, v[j].w * rs * ww.w}; }
}

static void gemm(hipStream_t st, const bf16_t* A, int lda, const bf16_t* Bt, int ldb, int Mr, int N, int K, const GemmEpi& E) {
    hipLaunchKernelGGL(k_gemm, dim3(N / 128, Mr / 128), dim3(256), 0, st, A, lda, Bt, ldb, K, E);
}

extern "C" void kernel_launch(void* const* d_in, const int* in_sizes, int n_in, void* d_out, int out_size, void* d_ws, size_t ws_size, hipStream_t stream) {
    if (n_in != 12 || out_size != M * D || ws_size < WS_END) { fprintf(stderr, "kernel_launch: unexpected sizes (n_in %d out %d ws %zu)\n", n_in, out_size, ws_size); return; }
    const float* x = (const float*)d_in[0]; const float* mem = (const float*)d_in[1]; const float* norm_w = (const float*)d_in[2]; const float* mem_norm_w = (const float*)d_in[3];
    const float* w_in = (const float*)d_in[4]; const float* b_merge = (const float*)d_in[5]; const float* w_mem_kv = (const float*)d_in[6];
    const float* w_a = (const float*)d_in[7]; const float* w_b = (const float*)d_in[8]; const float* w_m = (const float*)d_in[9]; const float* w_out = (const float*)d_in[10];
    const float* final_w = (const float*)d_in[11];
    char* ws = (char*)d_ws; float* out = (float*)d_out;
    bf16_t* WIN = (bf16_t*)(ws + WS_WIN); bf16_t* WA = (bf16_t*)(ws + WS_WA); bf16_t* WB = (bf16_t*)(ws + WS_WB); bf16_t* WM = (bf16_t*)(ws + WS_WM); bf16_t* WO = (bf16_t*)(ws + WS_WO);
    bf16_t* XN = (bf16_t*)(ws + WS_XN); bf16_t* MQ = (bf16_t*)(ws + WS_MQ); bf16_t* MG = (bf16_t*)(ws + WS_MG);
    bf16_t* KM = (bf16_t*)(ws + WS_KM); bf16_t* VM = (bf16_t*)(ws + WS_VM); float* kmean = (float*)(ws + WS_KMEAN);
    bf16_t* R1 = (bf16_t*)(ws + WS_R1);
    auto slot = [&](int s) { return (bf16_t*)(ws + WS_R1 + (size_t)s * SLOT); };
    bf16_t* BQ = (bf16_t*)((char*)d_out + 0 * SLOT); bf16_t* BK = (bf16_t*)((char*)d_out + 1 * SLOT); bf16_t* BV = (bf16_t*)((char*)d_out + 2 * SLOT); bf16_t* BG = (bf16_t*)((char*)d_out + 3 * SLOT);

    hipLaunchKernelGGL(k_transpose_w, dim3(DIN / 32, 1024 / 32), dim3(256), 0, stream, w_in, 1024, DIN, WIN);
    hipLaunchKernelGGL(k_transpose_w, dim3(1024 / 32, 512 / 32), dim3(256), 0, stream, w_a, 512, 1024, WA);
    hipLaunchKernelGGL(k_transpose_w, dim3(1024 / 32, 512 / 32), dim3(256), 0, stream, w_b, 512, 1024, WB);
    hipLaunchKernelGGL(k_transpose_w, dim3(1024 / 32, 256 / 32), dim3(256), 0, stream, w_m, 256, 1024, WM);
    hipLaunchKernelGGL(k_transpose_w, dim3(1024 / 32, 1024 / 32), dim3(256), 0, stream, w_out, 1024, 1024, WO);
    hipLaunchKernelGGL(k_rmsnorm_bf16, dim3(M / 4), dim3(256), 0, stream, x, norm_w, XN, M);
    hipLaunchKernelGGL(k_memkv, dim3(512 * 512 / 256), dim3(256), 0, stream, mem, mem_norm_w, w_mem_kv, KM, VM);

    GemmEpi E{}; E.scale = 1.f;
    for (int g = 0; g < 3; ++g) {
        E.mode = 0; E.ldc = 512;
        E.scale = C2; E.dst = slot(slot_q(g)); gemm(stream, XN, 1024, WIN + (size_t)(1536 * g) * 1024, 1024, M, 512, 1024, E);
        E.scale = 1.f; E.dst = slot(slot_k(g)); gemm(stream, XN, 1024, WIN + (size_t)(1536 * g + 512) * 1024, 1024, M, 512, 1024, E);
        E.dst = slot(slot_v(g)); gemm(stream, XN, 1024, WIN + (size_t)(1536 * g + 1024) * 1024, 1024, M, 512, 1024, E);
    }
    E.mode = 1; E.dst = slot(SLOT_AG); gemm(stream, XN, 1024, WIN + (size_t)4608 * 1024, 1024, M, 512, 1024, E);
    E.mode = 0; E.scale = C2; E.dst = BQ; gemm(stream, XN, 1024, WIN + (size_t)5120 * 1024, 1024, M, 512, 1024, E);
    E.scale = 1.f; E.dst = BK; gemm(stream, XN, 1024, WIN + (size_t)5632 * 1024, 1024, M, 512, 1024, E);
    E.dst = BV; gemm(stream, XN, 1024, WIN + (size_t)6144 * 1024, 1024, M, 512, 1024, E);
    E.mode = 1; E.dst = BG; gemm(stream, XN, 1024, WIN + (size_t)6656 * 1024, 1024, M, 512, 1024, E);
    E.mode = 0; E.scale = C2; E.ldc = 256; E.dst = MQ; gemm(stream, XN, 1024, WIN + (size_t)7168 * 1024, 1024, M, 256, 1024, E);
    E.mode = 1; E.scale = 1.f; E.dst = MG; gemm(stream, XN, 1024, WIN + (size_t)7424 * 1024, 1024, M, 256, 1024, E);

    hipLaunchKernelGGL(k_mixA_gold, dim3(M * 8 / 64), dim3(64), 0, stream, R1);
    hipLaunchKernelGGL(k_kmean_gold, dim3(16 * 64 * 64 / 256), dim3(256), 0, stream, BK, kmean);
    hipLaunchKernelGGL(k_moba_gold, dim3(M * 8 / 64), dim3(64), 0, stream, BQ, BK, BV, BG, kmean);
    hipLaunchKernelGGL(k_mem_gold, dim3(M * 4 / 64), dim3(64), 0, stream, MQ, KM, VM, MG);

    bf16_t* GA = slot(0); bf16_t* GB = slot(2); bf16_t* GM = slot(4);
    E.mode = 2; E.ldc = 1024;
    E.dst = GA; E.bias = b_merge; gemm(stream, XN, 1024, WIN + (size_t)7680 * 1024, 1024, M, 1024, 1024, E);
    E.dst = GB; E.bias = b_merge + 1024; gemm(stream, XN, 1024, WIN + (size_t)8704 * 1024, 1024, M, 1024, 1024, E);
    E.dst = GM; E.bias = b_merge + 2048; gemm(stream, XN, 1024, WIN + (size_t)9728 * 1024, 1024, M, 1024, 1024, E);

    bf16_t* MRG = XN;
    E.mode = 3; E.dst = MRG; E.ldc = 1024; E.ldg = 1024;
    E.gate = GA; E.first = 1; gemm(stream, slot(SLOT_AG), 512, WA, 512, M, 1024, 512, E);
    E.gate = GB; E.first = 0; gemm(stream, BG, 512, WB, 512, M, 1024, 512, E);
    E.gate = GM; E.first = 0; gemm(stream, MG, 256, WM, 256, M, 1024, 256, E);

    E.mode = 4; E.xres = x; E.dstf = out; E.ldc = 1024;
    gemm(stream, MRG, 1024, WO, 1024, M, 1024, 1024, E);
    hipLaunchKernelGGL(k_final_norm, dim3(M / 4), dim3(256), 0, stream, out, final_w, M);
}
```

```cpp
#include <hip/hip_runtime.h>
#include <stdint.h>
#include <stdio.h>

typedef float f32x16 __attribute__((ext_vector_type(16)));
typedef unsigned u32x2 __attribute__((ext_vector_type(2)));

constexpr int NB = 2, S = 16384, D = 1024, M = NB * S;
constexpr int DIN = 10752;
constexpr float EPS = 1e-6f;
constexpr float LOG2E = 1.4426950408889634f;
constexpr float LN2 = 0.6931471805599453f;
constexpr float C2 = 0.125f * LOG2E;

constexpr size_t MiB = 1u << 20;
constexpr size_t WS_CTL = 0, CTL_ZERO_BYTES = 1 * MiB;
constexpr size_t WS_KMEAN = 2 * MiB;
constexpr size_t WS_KM = 3 * MiB;
constexpr size_t WS_VM = 3 * MiB + 512 * 1024;
constexpr size_t WS_W = 12 * MiB;
constexpr size_t WS_WIN = WS_W;
constexpr size_t WS_WA = WS_WIN + (size_t)DIN * 1024 * 2;
constexpr size_t WS_WB = WS_WA + (size_t)1024 * 512 * 2;
constexpr size_t WS_WM = WS_WB + (size_t)1024 * 512 * 2;
constexpr size_t WS_WO = WS_WM + (size_t)1024 * 256 * 2;
constexpr size_t WS_XN = 40 * MiB;
constexpr size_t WS_MQ = 104 * MiB;
constexpr size_t WS_MG = 120 * MiB;
constexpr size_t WS_LIST = 136 * MiB;
constexpr size_t WS_R1 = 168 * MiB;
constexpr size_t SLOT = 32 * MiB;
constexpr size_t WS_END = WS_R1 + 10 * SLOT;
__host__ __device__ constexpr int slot_q(int g) { return g; }
__host__ __device__ constexpr int slot_k(int g) { return 3 + 2 * g; }
__host__ __device__ constexpr int slot_v(int g) { return 4 + 2 * g; }
constexpr int SLOT_AG = 9;
constexpr int CW_BAR = 4096;

namespace pg8 {
#define PG8_LAS __attribute__((address_space(3)))
typedef unsigned short bf16_t;
typedef short bf16x8 __attribute__((ext_vector_type(8)));
typedef float f32x4 __attribute__((ext_vector_type(4)));
typedef unsigned u32x4 __attribute__((ext_vector_type(4)));
constexpr int BM = 256, BK = 64, HALF = 128, HTB = HALF * BK * 2  , STAGE_BYTES = 8 * HTB, NXCD = 8, WGM = 8;

__host__ __device__ __forceinline__ int lds_byte(int r, int c) { const int st = (r >> 4) * 2 + (c >> 5), rr = r & 15, cc = c & 31, ob = rr * 64 + cc * 2; return st * 1024 + (ob ^ (((ob >> 9) & 1) << 5)); }
__host__ __device__ __forceinline__ void stage_rc(int b, int& R, int& C) { const int st = b / 1024, sb = b % 1024, swz = sb ^ (((sb >> 9) & 1) << 5); R = (st >> 1) * 16 + swz / 64; C = (st & 1) * 32 + (swz % 64) / 2; }
__host__ __device__ __forceinline__ int perm32(int rho) { const int n = rho >> 4, i = rho & 15; return 8 * (i >> 2) + 4 * n + (i & 3); }

struct Unit { int pm, pn; };
struct Gemm { const bf16_t* A; const bf16_t* Bt; int M, N, K; };

struct StaticOrder {
    int nM, nN, nwg, G, c;
    __host__ __device__ void init(int M, int N, int G_, int c_) { nM = M / BM; nN = N / BM; nwg = nM * nN; G = G_; c = c_; }
    __host__ __device__ bool next(int i, Unit& u) const {
        const long L = (long)i * G + c; if (L >= nwg) return false;
        int wgid = (int)L; { const int q = nwg / NXCD, r = nwg % NXCD, xcd = wgid % NXCD, off = wgid / NXCD; wgid = (xcd < r ? xcd * (q + 1) : r * (q + 1) + (xcd - r) * q) + off; }
        const int nig = WGM * nN, gid = wgid / nig, fm = gid * WGM, gsz = (nM - fm) < WGM ? (nM - fm) : WGM;
        u.pm = fm + ((wgid % nig) % gsz); u.pn = (wgid % nig) / gsz; return true;
    }
    __device__ __forceinline__ void a_ready(const Unit&) const {}
    __device__ __forceinline__ void done(const Unit&) const {}
};

__device__ __forceinline__ unsigned cvt_pk_bf16(float lo, float hi) { unsigned r; asm volatile("v_cvt_pk_bf16_f32 %0, %1, %2" : "=v"(r) : "v"(lo), "v"(hi)); return r; }

__device__ __forceinline__ float bf_lo(unsigned w) { return __uint_as_float(w << 16); }
__device__ __forceinline__ float bf_hi(unsigned w) { return __uint_as_float(w & 0xffff0000u); }
__device__ __forceinline__ float silu_f(float v) { return v * __builtin_amdgcn_rcpf(1.f + __builtin_amdgcn_exp2f(-1.4426950408889634f * v)); }
__device__ __forceinline__ float sigmoid_f(float v) { return __builtin_amdgcn_rcpf(1.f + __builtin_amdgcn_exp2f(-1.4426950408889634f * v)); }
struct EpiProj {
    static constexpr bool PERM = true, AFTER_DRAIN = false;
    unsigned char* ws; unsigned char* dout; const float* b_merge; int pn_off;
    __device__ __forceinline__ void operator()(const f32x4 (&acc)[2][2][4][2], const Unit& u, int wr, int wc, int fr, int fq) const {
        const int pn = u.pn + pn_off;
        bf16_t* base; int ldc = 512, colt, mode = 0; float sc = 1.f; const float* bias = nullptr;
        if (pn < 18) { const int g = pn / 6, w = pn % 6, pc = w >> 1; colt = (w & 1) * 256;
            const int sl = (pc == 0) ? g : (pc == 1) ? (3 + 2 * g) : (4 + 2 * g);
            base = (bf16_t*)(ws + WS_R1 + (size_t)sl * SLOT); if (pc == 0) sc = C2; }
        else if (pn < 20) { base = (bf16_t*)(ws + WS_R1 + 9ull * SLOT); colt = (pn - 18) * 256; mode = 1; }
        else if (pn < 28) { const int w = pn - 20, pc = w >> 1; colt = (w & 1) * 256; base = (bf16_t*)(dout + (size_t)pc * SLOT); if (pc == 0) sc = C2; if (pc == 3) mode = 1; }
        else if (pn == 28) { base = (bf16_t*)(ws + WS_MQ); ldc = 256; colt = 0; sc = C2; }
        else if (pn == 29) { base = (bf16_t*)(ws + WS_MG); ldc = 256; colt = 0; mode = 1; }
        else { const int w = pn - 30, t = w >> 2; base = (bf16_t*)(ws + WS_R1 + (size_t)(2 * t) * SLOT); ldc = 1024; colt = (w & 3) * 256; mode = 2; bias = b_merge + w * 256; }
        const int row0 = u.pm * BM + wr * 64 + fr, col0 = colt + wc * 32 + 8 * fq, bcol0 = wc * 32 + 8 * fq;
        f32x4 bv[2][2];
#pragma unroll
        for (int bj = 0; bj < 2; ++bj)
#pragma unroll
            for (int n = 0; n < 2; ++n) bv[bj][n] = (mode == 2) ? *(const f32x4*)(bias + bcol0 + bj * HALF + 4 * n) : (f32x4){0.f, 0.f, 0.f, 0.f};
#pragma unroll
        for (int ai = 0; ai < 2; ++ai)
#pragma unroll
            for (int m = 0; m < 4; ++m) { bf16_t* rowp = base + (size_t)(row0 + ai * HALF + m * 16) * ldc + col0;
#pragma unroll
                for (int bj = 0; bj < 2; ++bj) { f32x4 v0 = acc[ai][bj][m][0], v1 = acc[ai][bj][m][1];
                    if (mode == 0) { v0 = v0 * sc; v1 = v1 * sc; }
                    else if (mode == 1) {
#pragma unroll
                        for (int j = 0; j < 4; ++j) { v0[j] = silu_f(v0[j]); v1[j] = silu_f(v1[j]); } }
                    else { v0 = v0 + bv[bj][0]; v1 = v1 + bv[bj][1];
#pragma unroll
                        for (int j = 0; j < 4; ++j) { v0[j] = sigmoid_f(v0[j]); v1[j] = sigmoid_f(v1[j]); } }
                    u32x4 w; w.x = cvt_pk_bf16(v0[0], v0[1]); w.y = cvt_pk_bf16(v0[2], v0[3]); w.z = cvt_pk_bf16(v1[0], v1[1]); w.w = cvt_pk_bf16(v1[2], v1[3]);
                    *(u32x4*)(rowp + bj * HALF) = w; } }
    }
};
struct EpiMerge {
    static constexpr bool PERM = true, AFTER_DRAIN = false;
    bf16_t* dst; const bf16_t* gate; int first;
    __device__ __forceinline__ void operator()(const f32x4 (&acc)[2][2][4][2], const Unit& u, int wr, int wc, int fr, int fq) const {
        const int row0 = u.pm * BM + wr * 64 + fr, col0 = u.pn * BM + wc * 32 + 8 * fq;
#pragma unroll
        for (int ai = 0; ai < 2; ++ai)
#pragma unroll
            for (int m = 0; m < 4; ++m) { const size_t off = (size_t)(row0 + ai * HALF + m * 16) * 1024 + col0;
#pragma unroll
                for (int bj = 0; bj < 2; ++bj) { const f32x4 v0 = acc[ai][bj][m][0], v1 = acc[ai][bj][m][1];
                    const u32x4 g = *(const u32x4*)(gate + off + bj * HALF);
                    u32x4 p = (u32x4){0u, 0u, 0u, 0u}; if (!first) p = *(const u32x4*)(dst + off + bj * HALF);
                    u32x4 w;
                    w.x = cvt_pk_bf16(bf_lo(p.x) + bf_lo(g.x) * v0[0], bf_hi(p.x) + bf_hi(g.x) * v0[1]);
                    w.y = cvt_pk_bf16(bf_lo(p.y) + bf_lo(g.y) * v0[2], bf_hi(p.y) + bf_hi(g.y) * v0[3]);
                    w.z = cvt_pk_bf16(bf_lo(p.z) + bf_lo(g.z) * v1[0], bf_hi(p.z) + bf_hi(g.z) * v1[1]);
                    w.w = cvt_pk_bf16(bf_lo(p.w) + bf_lo(g.w) * v1[2], bf_hi(p.w) + bf_hi(g.w) * v1[3]);
                    *(u32x4*)(dst + off + bj * HALF) = w; } }
    }
};
struct EpiOut {
    static constexpr bool PERM = false, AFTER_DRAIN = false;
    const float* x; float* out;
    __device__ __forceinline__ void operator()(const f32x4 (&acc)[2][2][4][2], const Unit& u, int wr, int wc, int fr, int fq) const {
        const int row0 = u.pm * BM + wr * 64 + fr, col0 = u.pn * BM + wc * 32 + 4 * fq;
#pragma unroll
        for (int ai = 0; ai < 2; ++ai)
#pragma unroll
            for (int m = 0; m < 4; ++m) { const size_t off = (size_t)(row0 + ai * HALF + m * 16) * 1024 + col0;
#pragma unroll
                for (int bj = 0; bj < 2; ++bj)
#pragma unroll
                    for (int n = 0; n < 2; ++n) *(f32x4*)(out + off + bj * HALF + n * 16) = *(const f32x4*)(x + off + bj * HALF + n * 16) + acc[ai][bj][m][n]; }
    }
};

template <class Epi, class Sched, bool ALIGN_EPI = false, bool SP2 = false>
__device__ __forceinline__ void gemm_phase(PG8_LAS unsigned char* lds, const Gemm g, const Sched& S, const Epi& E) {
    const int tid = threadIdx.x, wid = __builtin_amdgcn_readfirstlane(tid >> 6), lane = tid & 63, wr = wid >> 2, wc = wid & 3, fr = lane & 15, fq = lane >> 4;
    const int K = g.K, nt = K / BK;
    unsigned voffA[2], voffB[2];
#pragma unroll
    for (int i = 0; i < 2; ++i) { int R, C; stage_rc(tid * 16 + i * 8192, R, C); const int Rb = Epi::PERM ? ((R & ~31) + perm32(R & 31)) : R;
        voffA[i] = (unsigned)(R * K + C) * 2u; voffB[i] = (unsigned)(Rb * K + C) * 2u; }
    const size_t kstep = (size_t)(BK * 2);
    const size_t hstep = (size_t)HALF * K * 2;
    const size_t tstep = 2 * hstep;
    const unsigned ldsw = (unsigned)wid * 1024u;
    const int aoff = lds_byte(wr * 64 + fr, fq * 8), boff = lds_byte(wc * 32 + fr, fq * 8);
#define PG8_SA(b, h) (((b) * 2 + (h)) * HTB)
#define PG8_SB(b, h) ((4 + (b) * 2 + (h)) * HTB)
#define PG8_STAGE(bufoff, gbase, voff) do { _Pragma("unroll") for (int _i = 0; _i < 2; ++_i) \
        __builtin_amdgcn_global_load_lds((const unsigned*)((const char*)(gbase) + (voff)[_i]), (PG8_LAS unsigned*)(lds + (bufoff) + ldsw + _i * 8192), 16, 0, 0); } while (0)
#define PG8_LDA(dst, b, h) do { _Pragma("unroll") for (int m = 0; m < 4; ++m) _Pragma("unroll") for (int k = 0; k < 2; ++k) dst[m][k] = *(const PG8_LAS bf16x8*)(lds + PG8_SA(b, h) + aoff + m * 2048 + k * 1024); } while (0)
#define PG8_LDB(dst, b, h) do { _Pragma("unroll") for (int n = 0; n < 2; ++n) _Pragma("unroll") for (int k = 0; k < 2; ++k) dst[n][k] = *(const PG8_LAS bf16x8*)(lds + PG8_SB(b, h) + boff + n * 2048 + k * 1024); } while (0)
#define PG8_MMA(ai, bj, At, Bt) do { __builtin_amdgcn_s_setprio(1); _Pragma("unroll") for (int m = 0; m < 4; ++m) _Pragma("unroll") for (int n = 0; n < 2; ++n) _Pragma("unroll") for (int k = 0; k < 2; ++k) \
        acc[ai][bj][m][n] = __builtin_amdgcn_mfma_f32_16x16x32_bf16(Bt[n][k], At[m][k], acc[ai][bj][m][n], 0, 0, 0); __builtin_amdgcn_s_setprio(0); } while (0)
#define PG8_WAIT_V(n) asm volatile("s_waitcnt vmcnt(" #n ")" ::: "memory")
#define PG8_WAIT_L(n) asm volatile("s_waitcnt lgkmcnt(" #n ")" ::: "memory")
#define PG8_BAR __builtin_amdgcn_s_barrier()
#define PG8_SCHED __builtin_amdgcn_sched_barrier(0)
    Unit cur, nxt; int ui = 0;
    if (!S.next(0, cur)) return;
    f32x4 acc[2][2][4][2];
#pragma unroll
    for (int a = 0; a < 2; ++a)
#pragma unroll
        for (int b = 0; b < 2; ++b)
#pragma unroll
            for (int m = 0; m < 4; ++m)
#pragma unroll
                for (int n = 0; n < 2; ++n) acc[a][b][m][n] = (f32x4){0.f, 0.f, 0.f, 0.f};
    bf16x8 At[4][2], B0[2][2], B1[2][2];
    const char* cA = (const char*)g.A + (size_t)cur.pm * tstep; const char* cB = (const char*)g.Bt + (size_t)cur.pn * tstep;
    S.a_ready(cur);
    if constexpr (SP2) {
        PG8_STAGE(PG8_SB(0, 0), cB, voffB); PG8_STAGE(PG8_SB(0, 1), cB + hstep, voffB); PG8_STAGE(PG8_SA(0, 0), cA, voffA); PG8_STAGE(PG8_SA(0, 1), cA + hstep, voffA);
        if (wr == 1) PG8_BAR;
        PG8_WAIT_V(2); PG8_BAR;
        PG8_STAGE(PG8_SB(1, 0), cB + kstep, voffB); PG8_STAGE(PG8_SA(1, 0), cA + kstep, voffA); PG8_STAGE(PG8_SB(1, 1), cB + hstep + kstep, voffB);
        PG8_WAIT_V(6); PG8_BAR;
    } else {
        PG8_STAGE(PG8_SB(0, 0), cB, voffB); PG8_STAGE(PG8_SA(0, 0), cA, voffA); PG8_STAGE(PG8_SB(0, 1), cB + hstep, voffB); PG8_STAGE(PG8_SA(0, 1), cA + hstep, voffA);
        if (wr == 1) PG8_BAR;
        PG8_WAIT_V(4); PG8_BAR;
        PG8_STAGE(PG8_SB(1, 0), cB + kstep, voffB); PG8_STAGE(PG8_SA(1, 0), cA + kstep, voffA); PG8_STAGE(PG8_SB(1, 1), cB + hstep + kstep, voffB);
        PG8_WAIT_V(6); PG8_BAR;
    }
    for (;;) {
        const bool has_next = S.next(ui + 1, nxt);
        const char* nA = has_next ? (const char*)g.A + (size_t)nxt.pm * tstep : cA; const char* nB = has_next ? (const char*)g.Bt + (size_t)nxt.pn * tstep : cB;
        for (int t = 0; t < nt; t += 2) {
            const bool last = (t == nt - 2);
            const char* a1 = cA + (size_t)(t + 1) * kstep;
            const char* a2 = last ? nA : cA + (size_t)(t + 2) * kstep; const char* b2 = last ? nB : cB + (size_t)(t + 2) * kstep;
            const char* a3 = a2 + kstep; const char* b3 = b2 + kstep;
            if (last && has_next) S.a_ready(nxt);
            if constexpr (SP2) {
            PG8_LDB(B0, 0, 0); PG8_LDB(B1, 0, 1); PG8_SCHED; PG8_LDA(At, 0, 0); PG8_STAGE(PG8_SA(1, 1), a1 + hstep, voffA);
            PG8_WAIT_V(8); PG8_WAIT_L(0); PG8_BAR; PG8_MMA(0, 0, At, B0); PG8_MMA(0, 1, At, B1); PG8_BAR; PG8_SCHED;
            PG8_LDA(At, 0, 1); PG8_STAGE(PG8_SB(0, 0), b2, voffB); PG8_STAGE(PG8_SB(0, 1), b2 + hstep, voffB); PG8_STAGE(PG8_SA(0, 0), a2, voffA);
            PG8_WAIT_V(8); PG8_WAIT_L(0); PG8_BAR; PG8_MMA(1, 0, At, B0); PG8_MMA(1, 1, At, B1); PG8_BAR; PG8_SCHED;
            PG8_LDB(B0, 1, 0); PG8_LDB(B1, 1, 1); PG8_SCHED; PG8_LDA(At, 1, 0); PG8_STAGE(PG8_SA(0, 1), a2 + hstep, voffA);
            PG8_WAIT_V(8); PG8_WAIT_L(0); PG8_BAR; PG8_MMA(0, 0, At, B0); PG8_MMA(0, 1, At, B1); PG8_BAR; PG8_SCHED;
            PG8_LDA(At, 1, 1); PG8_STAGE(PG8_SB(1, 0), b3, voffB); PG8_STAGE(PG8_SB(1, 1), b3 + hstep, voffB); PG8_STAGE(PG8_SA(1, 0), a3, voffA);
            PG8_WAIT_V(8); PG8_WAIT_L(0); PG8_BAR; PG8_MMA(1, 0, At, B0); PG8_MMA(1, 1, At, B1); PG8_BAR; PG8_SCHED;
            } else {
            PG8_LDB(B0, 0, 0); PG8_SCHED; PG8_LDA(At, 0, 0); PG8_STAGE(PG8_SA(1, 1), a1 + hstep, voffA);
            PG8_WAIT_L(8); PG8_BAR; PG8_WAIT_L(0); PG8_MMA(0, 0, At, B0); PG8_BAR; PG8_SCHED;
            PG8_LDB(B1, 0, 1); PG8_STAGE(PG8_SB(0, 0), b2, voffB);
            PG8_BAR; PG8_WAIT_L(0); PG8_MMA(0, 1, At, B1); PG8_BAR;
            PG8_LDA(At, 0, 1); PG8_STAGE(PG8_SA(0, 0), a2, voffA);
            PG8_BAR; PG8_WAIT_L(0); PG8_MMA(1, 0, At, B0); PG8_BAR; PG8_SCHED;
            PG8_STAGE(PG8_SB(0, 1), b2 + hstep, voffB);
            PG8_WAIT_V(6); PG8_BAR; PG8_MMA(1, 1, At, B1); PG8_BAR;
            PG8_LDB(B0, 1, 0); PG8_SCHED; PG8_LDA(At, 1, 0); PG8_STAGE(PG8_SA(0, 1), a2 + hstep, voffA);
            PG8_WAIT_L(8); PG8_BAR; PG8_WAIT_L(0); PG8_MMA(0, 0, At, B0); PG8_BAR; PG8_SCHED;
            PG8_LDB(B1, 1, 1); PG8_STAGE(PG8_SB(1, 0), b3, voffB);
            PG8_BAR; PG8_WAIT_L(0); PG8_MMA(0, 1, At, B1); PG8_BAR;
            PG8_LDA(At, 1, 1); PG8_STAGE(PG8_SA(1, 0), a3, voffA);
            PG8_BAR; PG8_WAIT_L(0); PG8_MMA(1, 0, At, B0); PG8_BAR; PG8_SCHED;
            PG8_STAGE(PG8_SB(1, 1), b3 + hstep, voffB);
            PG8_WAIT_V(6); PG8_BAR; PG8_MMA(1, 1, At, B1); PG8_BAR;
            }
        }
        if constexpr (ALIGN_EPI) { if (wr == 0) PG8_BAR; }
        if constexpr (!Epi::AFTER_DRAIN) { E(acc, cur, wr, wc, fr, fq); S.done(cur); }
        if (!has_next) break;
#pragma unroll
        for (int a = 0; a < 2; ++a)
#pragma unroll
            for (int b = 0; b < 2; ++b)
#pragma unroll
                for (int m = 0; m < 4; ++m)
#pragma unroll
                    for (int n = 0; n < 2; ++n) acc[a][b][m][n] = (f32x4){0.f, 0.f, 0.f, 0.f};
        cur = nxt; cA = nA; cB = nB; ++ui;
        if constexpr (ALIGN_EPI) { if (wr == 1) PG8_BAR; }
    }
    PG8_WAIT_V(0);
    if constexpr (!ALIGN_EPI) { if (wr == 0) PG8_BAR; }
    PG8_BAR;
    if constexpr (Epi::AFTER_DRAIN) { E.fused(acc, cur, wr, wc, fr, fq, lds, wid, lane); S.done(cur); }
#undef PG8_SA
#undef PG8_SB
#undef PG8_STAGE
#undef PG8_LDA
#undef PG8_LDB
#undef PG8_MMA
#undef PG8_WAIT_V
#undef PG8_WAIT_L
#undef PG8_BAR
#undef PG8_SCHED
}
}

#define GAS __attribute__((address_space(1)))
#define LAS __attribute__((address_space(3)))
typedef unsigned short bf16_t;
typedef unsigned v4u __attribute__((ext_vector_type(4)));
typedef float f32x4 __attribute__((ext_vector_type(4)));
typedef unsigned u32x4 __attribute__((ext_vector_type(4)));
#define LDS_WAIT() asm volatile("s_waitcnt lgkmcnt(0)" ::: "memory")
__device__ __forceinline__ unsigned f2bf(float f) { unsigned u = __builtin_bit_cast(unsigned, f); return (u + 0x7fffu + ((u >> 16) & 1u)) >> 16; }
__device__ __forceinline__ unsigned pk2(float lo, float hi) { return f2bf(lo) | (f2bf(hi) << 16); }
__device__ __forceinline__ float bf2f(bf16_t v) { return __uint_as_float(((unsigned)v) << 16); }
__device__ __forceinline__ float wave_sum(float v) {
#pragma unroll
    for (int o = 1; o < 64; o <<= 1) v += __shfl_xor(v, o);
    return v;
}
constexpr int NWAVES = 8;
constexpr int RING_OFF = 0, RING_BYTES = 131072;
constexpr int LDSCTL_OFF = RING_BYTES, MISC_OFF = LDSCTL_OFF + 320;
constexpr int LDS_BYTES = 147456;

#define XB_TMO      128
#define XB_XCNT(j)  (256  + 64 * (j))
#define XB_XSUB(j)  (1280 + 64 * (j))
#define XB_XGEN(j)  (2304 + 64 * (j))
#define XB_TOP      3328
#define XB_TOPGEN   3392
#define XCD_BAR_WORDS 3456
#define XB_SPIN_CAP (1u << 18)

__device__ __forceinline__ unsigned xb_ld(unsigned* p)              { return __hip_atomic_load(p, __ATOMIC_RELAXED, __HIP_MEMORY_SCOPE_AGENT); }
__device__ __forceinline__ unsigned xb_add(unsigned* p, unsigned v) { return __hip_atomic_fetch_add(p, v, __ATOMIC_RELAXED, __HIP_MEMORY_SCOPE_AGENT); }
__device__ __forceinline__ unsigned xb_xcc_id() { return (unsigned)__builtin_amdgcn_s_getreg((3 << 11) | 20) & 0xFu; }
#define XB_SPIN(cond, bar) do { unsigned _sp = 0; while (cond) { __builtin_amdgcn_s_sleep(1); \
    if ((++_sp & 255u) == 0u) { if (xb_ld(&(bar)[XB_TMO])) break; if (_sp > XB_SPIN_CAP) { atomicAdd(&(bar)[XB_TMO], 1u); break; } } } } while (0)

struct XcdBarrier {
    unsigned* bar; unsigned x;
    volatile LAS unsigned* st;
};

__device__ __forceinline__ XcdBarrier xcd_barrier_post(unsigned* bar, volatile LAS unsigned* st) {
    XcdBarrier b; b.bar = bar; b.x = xb_xcc_id(); b.st = st;
    if (threadIdx.x == 0) (void)xb_add(&bar[XB_XCNT(b.x)], 1u);
    return b;
}
__device__ __forceinline__ void xcd_barrier_complete(unsigned* bar, unsigned x, unsigned& nloc, unsigned& nx) {
    const unsigned G = gridDim.x * gridDim.y * gridDim.z;
    unsigned sum, cnt, mine, sp = 0u;
    for (;;) {
        sum = 0u; cnt = 0u; mine = 0u;
#pragma unroll
        for (unsigned j = 0; j < 16; ++j) { const unsigned c = xb_ld(&bar[XB_XCNT(j)]); sum += c; cnt += (c > 0u) ? 1u : 0u; mine = (j == x) ? c : mine; }
        if (sum == G) break;
        __builtin_amdgcn_s_sleep(1);
        if ((++sp & 255u) == 0u) { if (xb_ld(&bar[XB_TMO])) break; if (sp > XB_SPIN_CAP) { atomicAdd(&bar[XB_TMO], 1u); break; } }
    }
    nloc = mine > 0u ? mine : 1u; nx = cnt > 0u ? cnt : 1u;
}

__device__ __forceinline__ void xcd_barrier(const XcdBarrier& b) {
    asm volatile("s_waitcnt vmcnt(0)" ::: "memory");
    __syncthreads();
    if (threadIdx.x == 0) {
        unsigned* bar = b.bar;
        __builtin_amdgcn_s_waitcnt(0);
        unsigned nloc = b.st[0], nx = b.st[1];
        if (nloc == 0u) { xcd_barrier_complete(bar, b.x, nloc, nx); b.st[0] = nloc; b.st[1] = nx; }
        const unsigned old = xb_add(&bar[XB_XSUB(b.x)], 1u);
        const unsigned gen = old / nloc;
        if (old + 1u == (gen + 1u) * nloc) {
            __builtin_amdgcn_fence(__ATOMIC_RELEASE, "agent");
            asm volatile("s_waitcnt vmcnt(0)" ::: "memory");
            const unsigned og = xb_add(&bar[XB_TOP], 1u);
            const unsigned tg = og / nx;
            if (og + 1u == (tg + 1u) * nx) xb_add(&bar[XB_TOPGEN], 1u);
            else XB_SPIN(xb_ld(&bar[XB_TOPGEN]) == tg, bar);
            __builtin_amdgcn_fence(__ATOMIC_ACQUIRE, "agent");
            xb_add(&bar[XB_XGEN(b.x)], 1u);
            asm volatile("s_waitcnt vmcnt(0)" ::: "memory");
        } else {
            XB_SPIN(xb_ld(&bar[XB_XGEN(b.x)]) == gen, bar);
            __builtin_amdgcn_fence(__ATOMIC_ACQUIRE, "agent");
            asm volatile("s_waitcnt vmcnt(0)" ::: "memory");
        }
    }
    __syncthreads();
}

struct Frame {
    LAS unsigned char* lds; volatile LAS unsigned* MISC;
    int tid, lane, wave, vcu, G;
    unsigned char* ws; unsigned char* dout;
    const float *x, *mem, *norm_w, *mem_norm_w, *w_in, *b_merge, *w_mem_kv, *w_a, *w_b, *w_m, *w_out, *final_w;
};
__device__ __forceinline__ void p0_transpose_item(const float* W, int K, int N, bf16_t* WT, LAS float* scr, int item, int lane) {
    const int nblk = N / 32, kb = item / nblk, nb = item % nblk, k0 = 64 * kb, n0 = 32 * nb;
#pragma unroll 8
    for (int i = 0; i < 32; ++i) { const int kk = 2 * i + (lane >> 5); scr[kk * 33 + (lane & 31)] = W[(size_t)(k0 + kk) * N + n0 + (lane & 31)]; }
    LDS_WAIT(); asm volatile("" ::: "memory");
    const int c = lane & 7;
#pragma unroll
    for (int j = 0; j < 4; ++j) { const int n = (lane >> 3) + 8 * j; const LAS float* s = scr + (8 * c) * 33 + n;
        v4u o; o.x = pk2(s[0 * 33], s[1 * 33]); o.y = pk2(s[2 * 33], s[3 * 33]); o.z = pk2(s[4 * 33], s[5 * 33]); o.w = pk2(s[6 * 33], s[7 * 33]);
        *(GAS v4u*)(WT + (size_t)(n0 + n) * K + k0 + 8 * c) = o; }
    LDS_WAIT(); asm volatile("" ::: "memory");
}
__device__ __forceinline__ void rms_row_to_bf16(int lane, const float* xrow, const float* w, bf16_t* orow) {
    const GAS f32x4* xr = (const GAS f32x4*)xrow + lane;
    f32x4 v[4]; float s = 0.f;
#pragma unroll
    for (int j = 0; j < 4; ++j) { v[j] = xr[64 * j]; s += (v[j].x * v[j].x + v[j].y * v[j].y) + (v[j].z * v[j].z + v[j].w * v[j].w); }
    const float rs = 1.f / sqrtf(wave_sum(s) * (1.f / D) + EPS);
    GAS unsigned long long* o8 = (GAS unsigned long long*)orow + lane;
#pragma unroll
    for (int j = 0; j < 4; ++j) { const f32x4 ww = ((const GAS f32x4*)w)[lane + 64 * j];
        o8[64 * j] = (unsigned long long)pk2(v[j].x * rs * ww.x, v[j].y * rs * ww.y) | ((unsigned long long)pk2(v[j].z * rs * ww.z, v[j].w * rs * ww.w) << 32); }
}
__device__ __forceinline__ void p0_prologue(Frame& F) {
    LAS float* scr = (LAS float*)(F.lds + RING_OFF + F.wave * 16384);
    const int gw = F.vcu * NWAVES + F.wave, NGW = F.G * NWAVES;
    constexpr int I_IN = (1024 / 64) * (DIN / 32), I_A = (512 / 64) * (1024 / 32), I_B = I_A, I_M = (256 / 64) * (1024 / 32), I_O = (1024 / 64) * (1024 / 32);
    constexpr int NITEMS = I_IN + I_A + I_B + I_M + I_O;
    for (int it = gw; it < NITEMS; it += NGW) {
        int r = it;
        if (r < I_IN) { p0_transpose_item(F.w_in, 1024, DIN, (bf16_t*)(F.ws + WS_WIN), scr, r, F.lane); continue; } r -= I_IN;
        if (r < I_A) { p0_transpose_item(F.w_a, 512, 1024, (bf16_t*)(F.ws + WS_WA), scr, r, F.lane); continue; } r -= I_A;
        if (r < I_B) { p0_transpose_item(F.w_b, 512, 1024, (bf16_t*)(F.ws + WS_WB), scr, r, F.lane); continue; } r -= I_B;
        if (r < I_M) { p0_transpose_item(F.w_m, 256, 1024, (bf16_t*)(F.ws + WS_WM), scr, r, F.lane); continue; } r -= I_M;
        p0_transpose_item(F.w_out, 1024, 1024, (bf16_t*)(F.ws + WS_WO), scr, r, F.lane);
    }
    bf16_t* XN = (bf16_t*)(F.ws + WS_XN);
    for (int m = gw; m < M; m += NGW) rms_row_to_bf16(F.lane, F.x + (size_t)m * D, F.norm_w, XN + (size_t)m * D);
    bf16_t* KM = (bf16_t*)(F.ws + WS_KM); bf16_t* VM = (bf16_t*)(F.ws + WS_VM);
    for (int idx = F.vcu * 512 + F.tid; idx < 512 * 512; idx += F.G * 512) {
        const int r = idx >> 9, n = idx & 511; const float* mr = F.mem + (size_t)r * D;
        float ss = 0.f, acc = 0.f;
        for (int k = 0; k < D; ++k) { const float a = mr[k]; ss += a * a; acc += a * F.mem_norm_w[k] * F.w_mem_kv[(size_t)k * 512 + n]; }
        const float v = acc * (1.0f / sqrtf(ss * (1.f / D) + EPS));
        if (n < 256) KM[(size_t)r * 256 + n] = (bf16_t)f2bf(v); else VM[(size_t)r * 256 + (n - 256)] = (bf16_t)f2bf(v);
    }
}

__device__ __forceinline__ void load64(const bf16_t* p, float* f) {
#pragma unroll
    for (int c = 0; c < 8; ++c) { const u32x4 w = *(const u32x4*)(p + 8 * c);
        f[8 * c + 0] = __uint_as_float(w.x << 16); f[8 * c + 1] = __uint_as_float(w.x & 0xffff0000u);
        f[8 * c + 2] = __uint_as_float(w.y << 16); f[8 * c + 3] = __uint_as_float(w.y & 0xffff0000u);
        f[8 * c + 4] = __uint_as_float(w.z << 16); f[8 * c + 5] = __uint_as_float(w.z & 0xffff0000u);
        f[8 * c + 6] = __uint_as_float(w.w << 16); f[8 * c + 7] = __uint_as_float(w.w & 0xffff0000u); }
}
#define ATT_STEP(krow, vrow, bias2) do { \
    float kk_[64]; load64((krow), kk_); float s_ = 0.f; \
    _Pragma("unroll") for (int d_ = 0; d_ < 64; ++d_) s_ += q[d_] * kk_[d_]; \
    s_ += (bias2); \
    const float mn_ = fmaxf(mrun, s_), f_ = exp2f(mrun - mn_), p_ = exp2f(s_ - mn_); \
    float vv_[64]; load64((vrow), vv_); \
    lrun = lrun * f_ + p_; mrun = mn_; \
    _Pragma("unroll") for (int d_ = 0; d_ < 64; ++d_) o[d_] = o[d_] * f_ + p_ * vv_[d_]; } while (0)
__device__ __forceinline__ void store_gated(bf16_t* gp, const float* o, float inv) {
#pragma unroll
    for (int c = 0; c < 8; ++c) { const u32x4 w = *(const u32x4*)(gp + 8 * c); u32x4 r;
        r.x = pk2(o[8 * c + 0] * inv * __uint_as_float(w.x << 16), o[8 * c + 1] * inv * __uint_as_float(w.x & 0xffff0000u));
        r.y = pk2(o[8 * c + 2] * inv * __uint_as_float(w.y << 16), o[8 * c + 3] * inv * __uint_as_float(w.y & 0xffff0000u));
        r.z = pk2(o[8 * c + 4] * inv * __uint_as_float(w.z << 16), o[8 * c + 5] * inv * __uint_as_float(w.z & 0xffff0000u));
        r.w = pk2(o[8 * c + 6] * inv * __uint_as_float(w.w << 16), o[8 * c + 7] * inv * __uint_as_float(w.w & 0xffff0000u));
        *(u32x4*)(gp + 8 * c) = r; }
}
__device__ __forceinline__ void gold_mixA(Frame& F) {
    unsigned char* R1 = F.ws + WS_R1;
    for (int idx = F.vcu * 512 + F.tid; idx < M * 8; idx += F.G * 512) {
        const int h = idx & 7, m = idx >> 3, b = m / S, t = m % S;
        const float slope2 = exp2f(-(float)h - 0.5f) * LOG2E;
        float o[64]; float mrun = -1e30f, lrun = 0.f;
#pragma unroll
        for (int d = 0; d < 64; ++d) o[d] = 0.f;
        for (int g = 0; g < 3; ++g) {
            const int dil = (g == 0) ? 1 : (g == 1) ? 4 : 16;
            const bf16_t* Q = (const bf16_t*)(R1 + (size_t)slot_q(g) * SLOT);
            const bf16_t* Kp = (const bf16_t*)(R1 + (size_t)slot_k(g) * SLOT);
            const bf16_t* Vp = (const bf16_t*)(R1 + (size_t)slot_v(g) * SLOT);
            float q[64]; load64(Q + (size_t)m * 512 + h * 64, q);
            for (int j = 0; j <= 128; ++j) {
                const int tk = t - j * dil; if (tk < 0) break;
                const size_t kr = ((size_t)b * S + tk) * 512 + h * 64;
                ATT_STEP(Kp + kr, Vp + kr, -slope2 * (float)(j * dil));
            }
        }
        bf16_t* AG = (bf16_t*)(R1 + (size_t)SLOT_AG * SLOT);
        store_gated(AG + (size_t)m * 512 + h * 64, o, 1.f / lrun);
    }
}
__device__ __forceinline__ void gold_kmean(Frame& F) {
    const bf16_t* BK = (const bf16_t*)(F.dout + 1 * SLOT); float* kmean = (float*)(F.ws + WS_KMEAN);
    for (int idx = F.vcu * 512 + F.tid; idx < 16 * 64 * 64; idx += F.G * 512) {
        const int d = idx & 63, n = (idx >> 6) & 63, bh = idx >> 12, b = bh >> 3, h = bh & 7;
        float s = 0.f;
        for (int r = 0; r < 256; ++r) s += bf2f(BK[((size_t)b * S + n * 256 + r) * 512 + h * 64 + d]);
        kmean[idx] = s * (1.f / 256.f);
    }
}
__device__ __forceinline__ void gold_moba(Frame& F) {
    const bf16_t* BQ = (const bf16_t*)(F.dout); const bf16_t* BK = (const bf16_t*)(F.dout + 1 * SLOT); const bf16_t* BV = (const bf16_t*)(F.dout + 2 * SLOT);
    bf16_t* BG = (bf16_t*)(F.dout + 3 * SLOT); const float* kmean = (const float*)(F.ws + WS_KMEAN);
    for (int idx = F.vcu * 512 + F.tid; idx < M * 8; idx += F.G * 512) {
        const int h = idx & 7, m = idx >> 3, b = m / S, t = m % S, qb = t >> 8;
        const float slope2 = exp2f(-(float)(h + 1)) * LOG2E;
        float q[64]; load64(BQ + (size_t)m * 512 + h * 64, q);
        float bv0 = -INFINITY, bv1 = -INFINITY, bv2 = -INFINITY; int bi0 = -1, bi1 = -1, bi2 = -1;
        const float* km = kmean + (size_t)(b * 8 + h) * 64 * 64;
        for (int n = 0; n < qb; ++n) {
            float s = 0.f;
#pragma unroll
            for (int d = 0; d < 64; ++d) s += q[d] * km[n * 64 + d];
            if (s > bv0) { bv2 = bv1; bi2 = bi1; bv1 = bv0; bi1 = bi0; bv0 = s; bi0 = n; }
            else if (s > bv1) { bv2 = bv1; bi2 = bi1; bv1 = s; bi1 = n; }
            else if (s > bv2) { bv2 = s; bi2 = n; }
        }
        float o[64]; float mrun = -1e30f, lrun = 0.f;
#pragma unroll
        for (int d = 0; d < 64; ++d) o[d] = 0.f;
        for (int j = 0; j < 4; ++j) {
            const int blk = (j == 0) ? bi0 : (j == 1) ? bi1 : (j == 2) ? bi2 : qb;
            if (blk < 0) continue;
            const int p0 = blk * 256;
            for (int kk = 0; kk < 256; ++kk) {
                const int pos = p0 + kk; if (pos > t) break;
                const size_t kr = ((size_t)b * S + pos) * 512 + h * 64;
                ATT_STEP(BK + kr, BV + kr, -slope2 * (float)(t - pos));
            }
        }
        store_gated(BG + (size_t)m * 512 + h * 64, o, 1.f / lrun);
    }
}
__device__ __forceinline__ void gold_mem(Frame& F) {
    const bf16_t* MQ = (const bf16_t*)(F.ws + WS_MQ); bf16_t* MG = (bf16_t*)(F.ws + WS_MG);
    const bf16_t* KM = (const bf16_t*)(F.ws + WS_KM); const bf16_t* VM = (const bf16_t*)(F.ws + WS_VM);
    for (int idx = F.vcu * 512 + F.tid; idx < M * 4; idx += F.G * 512) {
        const int h = idx & 3, m = idx >> 2, b = m / S;
        float q[64]; load64(MQ + (size_t)m * 256 + h * 64, q);
        float o[64]; float mrun = -1e30f, lrun = 0.f;
#pragma unroll
        for (int d = 0; d < 64; ++d) o[d] = 0.f;
        for (int j = 0; j < 256; ++j) {
            const size_t kr = ((size_t)b * 256 + j) * 256 + h * 64;
            ATT_STEP(KM + kr, VM + kr, 0.f);
        }
        store_gated(MG + (size_t)m * 256 + h * 64, o, 1.f / lrun);
    }
}
__device__ __forceinline__ void final_norm_rows(Frame& F) {
    const int gw = F.vcu * NWAVES + F.wave, NGW = F.G * NWAVES; float* out = (float*)F.dout;
    for (int row = gw; row < M; row += NGW) {
        GAS f32x4* xr = (GAS f32x4*)(out + (size_t)row * D) + F.lane;
        f32x4 v[4]; float s = 0.f;
#pragma unroll
        for (int j = 0; j < 4; ++j) { v[j] = xr[64 * j]; s += (v[j].x * v[j].x + v[j].y * v[j].y) + (v[j].z * v[j].z + v[j].w * v[j].w); }
        const float rs = 1.0f / sqrtf(wave_sum(s) * (1.f / D) + EPS);
#pragma unroll
        for (int j = 0; j < 4; ++j) { const f32x4 ww = ((const GAS f32x4*)F.final_w)[F.lane + 64 * j]; xr[64 * j] = (f32x4){v[j].x * rs * ww.x, v[j].y * rs * ww.y, v[j].z * rs * ww.z, v[j].w * rs * ww.w}; }
    }
}

struct Args { const float* in[12]; float* out; unsigned char* ws; };
__global__ void __launch_bounds__(NWAVES * 64, 2) mk_fwd(Args args) {
    extern __shared__ __attribute__((aligned(16))) unsigned char lds[];
    Frame F;
    F.lds = (LAS unsigned char*)lds; F.MISC = (volatile LAS unsigned*)(F.lds + MISC_OFF);
    F.tid = threadIdx.x; F.lane = F.tid & 63; F.wave = __builtin_amdgcn_readfirstlane(F.tid >> 6);
    F.G = gridDim.x; { const int bx = blockIdx.x; F.vcu = (F.G % 8 == 0) ? (bx % 8) * (F.G / 8) + bx / 8 : bx; }
    F.ws = args.ws; F.dout = (unsigned char*)args.out;
    F.x = args.in[0]; F.mem = args.in[1]; F.norm_w = args.in[2]; F.mem_norm_w = args.in[3]; F.w_in = args.in[4]; F.b_merge = args.in[5]; F.w_mem_kv = args.in[6];
    F.w_a = args.in[7]; F.w_b = args.in[8]; F.w_m = args.in[9]; F.w_out = args.in[10]; F.final_w = args.in[11];
    for (int u = F.tid; u < (LDS_BYTES - LDSCTL_OFF) / 4; u += NWAVES * 64) ((LAS unsigned*)(F.lds + LDSCTL_OFF))[u] = 0u;
    __syncthreads();
    XcdBarrier bar = xcd_barrier_post((unsigned*)(F.ws + WS_CTL) + CW_BAR, F.MISC + 8);
#define GRID_BAR() xcd_barrier(bar)
    bf16_t* WIN = (bf16_t*)(F.ws + WS_WIN); bf16_t* XN = (bf16_t*)(F.ws + WS_XN);

    p0_prologue(F); GRID_BAR();
    { pg8::Gemm g{XN, WIN, M, 30 * 256, 1024}; pg8::StaticOrder So; So.init(M, 30 * 256, F.G, (int)blockIdx.x);
      pg8::EpiProj E{F.ws, F.dout, F.b_merge, 0};
      pg8::gemm_phase<pg8::EpiProj, pg8::StaticOrder, true, true>(F.lds + RING_OFF, g, So, E); }
    GRID_BAR();
    gold_mixA(F); gold_kmean(F); gold_mem(F); GRID_BAR();
    gold_moba(F); GRID_BAR();
    { pg8::Gemm g{XN, WIN + (size_t)30 * 256 * 1024, M, 12 * 256, 1024}; pg8::StaticOrder So; So.init(M, 12 * 256, F.G, (int)blockIdx.x);
      pg8::EpiProj E{F.ws, F.dout, F.b_merge, 30};
      pg8::gemm_phase<pg8::EpiProj, pg8::StaticOrder, true, true>(F.lds + RING_OFF, g, So, E); }
    GRID_BAR();
    { bf16_t* MRG = XN; pg8::StaticOrder So; So.init(M, 1024, F.G, (int)blockIdx.x);
      { pg8::Gemm g{(const bf16_t*)(F.ws + WS_R1 + (size_t)SLOT_AG * SLOT), (const bf16_t*)(F.ws + WS_WA), M, 1024, 512};
        pg8::EpiMerge E{MRG, (const bf16_t*)(F.ws + WS_R1 + 0 * SLOT), 1}; pg8::gemm_phase<pg8::EpiMerge, pg8::StaticOrder, true, true>(F.lds + RING_OFF, g, So, E); }
      { pg8::Gemm g{(const bf16_t*)(F.dout + 3 * SLOT), (const bf16_t*)(F.ws + WS_WB), M, 1024, 512};
        pg8::EpiMerge E{MRG, (const bf16_t*)(F.ws + WS_R1 + 2 * SLOT), 0}; pg8::gemm_phase<pg8::EpiMerge, pg8::StaticOrder, true, true>(F.lds + RING_OFF, g, So, E); }
      { pg8::Gemm g{(const bf16_t*)(F.ws + WS_MG), (const bf16_t*)(F.ws + WS_WM), M, 1024, 256};
        pg8::EpiMerge E{MRG, (const bf16_t*)(F.ws + WS_R1 + 4 * SLOT), 0}; pg8::gemm_phase<pg8::EpiMerge, pg8::StaticOrder, true, true>(F.lds + RING_OFF, g, So, E); } }
    GRID_BAR();
    { pg8::Gemm g{XN, (const bf16_t*)(F.ws + WS_WO), M, 1024, 1024}; pg8::StaticOrder So; So.init(M, 1024, F.G, (int)blockIdx.x);
      pg8::EpiOut E{F.x, (float*)F.dout}; pg8::gemm_phase<pg8::EpiOut, pg8::StaticOrder, true, true>(F.lds + RING_OFF, g, So, E); }
    GRID_BAR();
    final_norm_rows(F);
}

extern "C" void kernel_launch(void* const* d_in, const int* in_sizes, int n_in, void* d_out, int out_size, void* d_ws, size_t ws_size, hipStream_t stream) {
    static int grid = 0;
    if (grid == 0) {
        if (n_in != 12 || out_size != M * D || ws_size < WS_END) { fprintf(stderr, "kernel_launch: unexpected sizes (n_in %d out %d ws %zu)\n", n_in, out_size, ws_size); grid = -1; return; }
        int dev = 0, cus = 0, per_cu = 0;
        if (hipGetDevice(&dev) != hipSuccess || hipDeviceGetAttribute(&cus, hipDeviceAttributeMultiprocessorCount, dev) != hipSuccess) { grid = -1; return; }
        if (hipFuncSetAttribute((const void*)mk_fwd, hipFuncAttributeMaxDynamicSharedMemorySize, LDS_BYTES) != hipSuccess) { fprintf(stderr, "kernel_launch: hipFuncSetAttribute failed\n"); grid = -1; return; }
        if (hipOccupancyMaxActiveBlocksPerMultiprocessor(&per_cu, (const void*)mk_fwd, NWAVES * 64, LDS_BYTES) != hipSuccess || per_cu < 1) { fprintf(stderr, "kernel_launch: occupancy query says %d blocks/CU\n", per_cu); (void)hipGetLastError(); grid = -1; return; }
        grid = cus;
    }
    if (grid < 0) return;
    if (hipMemsetAsync((char*)d_ws + WS_CTL, 0, CTL_ZERO_BYTES, stream) != hipSuccess) return;
    Args a{};
    for (int i = 0; i < 12; ++i) a.in[i] = (const float*)d_in[i];
    a.out = (float*)d_out; a.ws = (unsigned char*)d_ws;
    void* kargs[] = {&a};
    hipError_t e = hipLaunchCooperativeKernel((const void*)mk_fwd, dim3(grid), dim3(NWAVES * 64), kargs, LDS_BYTES, stream);
    if (e != hipSuccess) fprintf(stderr, "kernel_launch: cooperative launch failed: %s (grid %d)\n", hipGetErrorString(e), grid);
}
```

```cpp
#include <hip/hip_runtime.h>
#include <stdint.h>
#include <stdio.h>

typedef float f32x16 __attribute__((ext_vector_type(16)));
typedef unsigned u32x2 __attribute__((ext_vector_type(2)));

constexpr int NB = 2, S = 16384, D = 1024, M = NB * S;
constexpr int DIN = 10752;
constexpr float EPS = 1e-6f;
constexpr float LOG2E = 1.4426950408889634f;
constexpr float LN2 = 0.6931471805599453f;
constexpr float C2 = 0.125f * LOG2E;

constexpr size_t MiB = 1u << 20;
constexpr size_t WS_CTL = 0, CTL_ZERO_BYTES = 1 * MiB;
constexpr size_t WS_KMEAN = 2 * MiB;
constexpr size_t WS_KM = 3 * MiB;
constexpr size_t WS_VM = 3 * MiB + 512 * 1024;
constexpr size_t WS_W = 12 * MiB;
constexpr size_t WS_WIN = WS_W;
constexpr size_t WS_WA = WS_WIN + (size_t)DIN * 1024 * 2;
constexpr size_t WS_WB = WS_WA + (size_t)1024 * 512 * 2;
constexpr size_t WS_WM = WS_WB + (size_t)1024 * 512 * 2;
constexpr size_t WS_WO = WS_WM + (size_t)1024 * 256 * 2;
constexpr size_t WS_XN = 40 * MiB;
constexpr size_t WS_MQ = 104 * MiB;
constexpr size_t WS_MG = 120 * MiB;
constexpr size_t WS_LIST = 136 * MiB;
constexpr size_t WS_R1 = 168 * MiB;
constexpr size_t SLOT = 32 * MiB;
constexpr size_t WS_END = WS_R1 + 10 * SLOT;
__host__ __device__ constexpr int slot_q(int g) { return g; }
__host__ __device__ constexpr int slot_k(int g) { return 3 + 2 * g; }
__host__ __device__ constexpr int slot_v(int g) { return 4 + 2 * g; }
constexpr int SLOT_AG = 9;
constexpr int CW_BAR = 4096;

namespace pg8 {
#define PG8_LAS __attribute__((address_space(3)))
typedef unsigned short bf16_t;
typedef short bf16x8 __attribute__((ext_vector_type(8)));
typedef float f32x4 __attribute__((ext_vector_type(4)));
typedef unsigned u32x4 __attribute__((ext_vector_type(4)));
constexpr int BM = 256, BK = 64, HALF = 128, HTB = HALF * BK * 2  , STAGE_BYTES = 8 * HTB, NXCD = 8, WGM = 8;

__host__ __device__ __forceinline__ int lds_byte(int r, int c) { const int st = (r >> 4) * 2 + (c >> 5), rr = r & 15, cc = c & 31, ob = rr * 64 + cc * 2; return st * 1024 + (ob ^ (((ob >> 9) & 1) << 5)); }
__host__ __device__ __forceinline__ void stage_rc(int b, int& R, int& C) { const int st = b / 1024, sb = b % 1024, swz = sb ^ (((sb >> 9) & 1) << 5); R = (st >> 1) * 16 + swz / 64; C = (st & 1) * 32 + (swz % 64) / 2; }
__host__ __device__ __forceinline__ int perm32(int rho) { const int n = rho >> 4, i = rho & 15; return 8 * (i >> 2) + 4 * n + (i & 3); }

struct Unit { int pm, pn; };
struct Gemm { const bf16_t* A; const bf16_t* Bt; int M, N, K; };

struct StaticOrder {
    int nM, nN, nwg, G, c;
    __host__ __device__ void init(int M, int N, int G_, int c_) { nM = M / BM; nN = N / BM; nwg = nM * nN; G = G_; c = c_; }
    __host__ __device__ bool next(int i, Unit& u) const {
        const long L = (long)i * G + c; if (L >= nwg) return false;
        int wgid = (int)L; { const int q = nwg / NXCD, r = nwg % NXCD, xcd = wgid % NXCD, off = wgid / NXCD; wgid = (xcd < r ? xcd * (q + 1) : r * (q + 1) + (xcd - r) * q) + off; }
        const int nig = WGM * nN, gid = wgid / nig, fm = gid * WGM, gsz = (nM - fm) < WGM ? (nM - fm) : WGM;
        u.pm = fm + ((wgid % nig) % gsz); u.pn = (wgid % nig) / gsz; return true;
    }
    __device__ __forceinline__ void a_ready(const Unit&) const {}
    __device__ __forceinline__ void done(const Unit&) const {}
};

__device__ __forceinline__ unsigned cvt_pk_bf16(float lo, float hi) { unsigned r; asm volatile("v_cvt_pk_bf16_f32 %0, %1, %2" : "=v"(r) : "v"(lo), "v"(hi)); return r; }

__device__ __forceinline__ float bf_lo(unsigned w) { return __uint_as_float(w << 16); }
__device__ __forceinline__ float bf_hi(unsigned w) { return __uint_as_float(w & 0xffff0000u); }
__device__ __forceinline__ float silu_f(float v) { return v * __builtin_amdgcn_rcpf(1.f + __builtin_amdgcn_exp2f(-1.4426950408889634f * v)); }
__device__ __forceinline__ float sigmoid_f(float v) { return __builtin_amdgcn_rcpf(1.f + __builtin_amdgcn_exp2f(-1.4426950408889634f * v)); }
struct EpiProj {
    static constexpr bool PERM = true, AFTER_DRAIN = false;
    unsigned char* ws; unsigned char* dout; const float* b_merge; int pn_off;
    __device__ __forceinline__ void operator()(const f32x4 (&acc)[2][2][4][2], const Unit& u, int wr, int wc, int fr, int fq) const {
        const int pn = u.pn + pn_off;
        bf16_t* base; int ldc = 512, colt, mode = 0; float sc = 1.f; const float* bias = nullptr;
        if (pn < 18) { const int g = pn / 6, w = pn % 6, pc = w >> 1; colt = (w & 1) * 256;
            const int sl = (pc == 0) ? g : (pc == 1) ? (3 + 2 * g) : (4 + 2 * g);
            base = (bf16_t*)(ws + WS_R1 + (size_t)sl * SLOT); if (pc == 0) sc = C2; }
        else if (pn < 20) { base = (bf16_t*)(ws + WS_R1 + 9ull * SLOT); colt = (pn - 18) * 256; mode = 1; }
        else if (pn < 28) { const int w = pn - 20, pc = w >> 1; colt = (w & 1) * 256; base = (bf16_t*)(dout + (size_t)pc * SLOT); if (pc == 0) sc = C2; if (pc == 3) mode = 1; }
        else if (pn == 28) { base = (bf16_t*)(ws + WS_MQ); ldc = 256; colt = 0; sc = C2; }
        else if (pn == 29) { base = (bf16_t*)(ws + WS_MG); ldc = 256; colt = 0; mode = 1; }
        else { const int w = pn - 30, t = w >> 2; base = (bf16_t*)(ws + WS_R1 + (size_t)(2 * t) * SLOT); ldc = 1024; colt = (w & 3) * 256; mode = 2; bias = b_merge + w * 256; }
        const int row0 = u.pm * BM + wr * 64 + fr, col0 = colt + wc * 32 + 8 * fq, bcol0 = wc * 32 + 8 * fq;
        f32x4 bv[2][2];
#pragma unroll
        for (int bj = 0; bj < 2; ++bj)
#pragma unroll
            for (int n = 0; n < 2; ++n) bv[bj][n] = (mode == 2) ? *(const f32x4*)(bias + bcol0 + bj * HALF + 4 * n) : (f32x4){0.f, 0.f, 0.f, 0.f};
#pragma unroll
        for (int ai = 0; ai < 2; ++ai)
#pragma unroll
            for (int m = 0; m < 4; ++m) { bf16_t* rowp = base + (size_t)(row0 + ai * HALF + m * 16) * ldc + col0;
#pragma unroll
                for (int bj = 0; bj < 2; ++bj) { f32x4 v0 = acc[ai][bj][m][0], v1 = acc[ai][bj][m][1];
                    if (mode == 0) { v0 = v0 * sc; v1 = v1 * sc; }
                    else if (mode == 1) {
#pragma unroll
                        for (int j = 0; j < 4; ++j) { v0[j] = silu_f(v0[j]); v1[j] = silu_f(v1[j]); } }
                    else { v0 = v0 + bv[bj][0]; v1 = v1 + bv[bj][1];
#pragma unroll
                        for (int j = 0; j < 4; ++j) { v0[j] = sigmoid_f(v0[j]); v1[j] = sigmoid_f(v1[j]); } }
                    u32x4 w; w.x = cvt_pk_bf16(v0[0], v0[1]); w.y = cvt_pk_bf16(v0[2], v0[3]); w.z = cvt_pk_bf16(v1[0], v1[1]); w.w = cvt_pk_bf16(v1[2], v1[3]);
                    *(u32x4*)(rowp + bj * HALF) = w; } }
    }
};
struct EpiMerge {
    static constexpr bool PERM = true, AFTER_DRAIN = false;
    bf16_t* dst; const bf16_t* gate; int first;
    __device__ __forceinline__ void operator()(const f32x4 (&acc)[2][2][4][2], const Unit& u, int wr, int wc, int fr, int fq) const {
        const int row0 = u.pm * BM + wr * 64 + fr, col0 = u.pn * BM + wc * 32 + 8 * fq;
#pragma unroll
        for (int ai = 0; ai < 2; ++ai)
#pragma unroll
            for (int m = 0; m < 4; ++m) { const size_t off = (size_t)(row0 + ai * HALF + m * 16) * 1024 + col0;
#pragma unroll
                for (int bj = 0; bj < 2; ++bj) { const f32x4 v0 = acc[ai][bj][m][0], v1 = acc[ai][bj][m][1];
                    const u32x4 g = *(const u32x4*)(gate + off + bj * HALF);
                    u32x4 p = (u32x4){0u, 0u, 0u, 0u}; if (!first) p = *(const u32x4*)(dst + off + bj * HALF);
                    u32x4 w;
                    w.x = cvt_pk_bf16(bf_lo(p.x) + bf_lo(g.x) * v0[0], bf_hi(p.x) + bf_hi(g.x) * v0[1]);
                    w.y = cvt_pk_bf16(bf_lo(p.y) + bf_lo(g.y) * v0[2], bf_hi(p.y) + bf_hi(g.y) * v0[3]);
                    w.z = cvt_pk_bf16(bf_lo(p.z) + bf_lo(g.z) * v1[0], bf_hi(p.z) + bf_hi(g.z) * v1[1]);
                    w.w = cvt_pk_bf16(bf_lo(p.w) + bf_lo(g.w) * v1[2], bf_hi(p.w) + bf_hi(g.w) * v1[3]);
                    *(u32x4*)(dst + off + bj * HALF) = w; } }
    }
};
struct EpiOut {
    static constexpr bool PERM = false, AFTER_DRAIN = false;
    const float* x; float* out;
    __device__ __forceinline__ void operator()(const f32x4 (&acc)[2][2][4][2], const Unit& u, int wr, int wc, int fr, int fq) const {
        const int row0 = u.pm * BM + wr * 64 + fr, col0 = u.pn * BM + wc * 32 + 4 * fq;
#pragma unroll
        for (int ai = 0; ai < 2; ++ai)
#pragma unroll
            for (int m = 0; m < 4; ++m) { const size_t off = (size_t)(row0 + ai * HALF + m * 16) * 1024 + col0;
#pragma unroll
                for (int bj = 0; bj < 2; ++bj)
#pragma unroll
                    for (int n = 0; n < 2; ++n) *(f32x4*)(out + off + bj * HALF + n * 16) = *(const f32x4*)(x + off + bj * HALF + n * 16) + acc[ai][bj][m][n]; }
    }
};

template <class Epi, class Sched, bool ALIGN_EPI = false, bool SP2 = false>
__device__ __forceinline__ void gemm_phase(PG8_LAS unsigned char* lds, const Gemm g, const Sched& S, const Epi& E) {
    int tid_ = threadIdx.x; asm volatile("" : "+v"(tid_));
    const int tid = tid_, wid = __builtin_amdgcn_readfirstlane(tid >> 6), lane = tid & 63, wr = wid >> 2, wc = wid & 3, fr = lane & 15, fq = lane >> 4;
    const int K = g.K, nt = K / BK;
    unsigned voffA[2], voffB[2];
#pragma unroll
    for (int i = 0; i < 2; ++i) { int R, C; stage_rc(tid * 16 + i * 8192, R, C); const int Rb = Epi::PERM ? ((R & ~31) + perm32(R & 31)) : R;
        voffA[i] = (unsigned)(R * K + C) * 2u; voffB[i] = (unsigned)(Rb * K + C) * 2u; }
    const size_t kstep = (size_t)(BK * 2);
    const size_t hstep = (size_t)HALF * K * 2;
    const size_t tstep = 2 * hstep;
    const unsigned ldsw = (unsigned)wid * 1024u;
    const int aoff = lds_byte(wr * 64 + fr, fq * 8), boff = lds_byte(wc * 32 + fr, fq * 8);
#define PG8_SA(b, h) (((b) * 2 + (h)) * HTB)
#define PG8_SB(b, h) ((4 + (b) * 2 + (h)) * HTB)
#define PG8_STAGE(bufoff, gbase, voff) do { _Pragma("unroll") for (int _i = 0; _i < 2; ++_i) \
        __builtin_amdgcn_global_load_lds((const unsigned*)((const char*)(gbase) + (voff)[_i]), (PG8_LAS unsigned*)(lds + (bufoff) + ldsw + _i * 8192), 16, 0, 0); } while (0)
#define PG8_LDA(dst, b, h) do { _Pragma("unroll") for (int m = 0; m < 4; ++m) _Pragma("unroll") for (int k = 0; k < 2; ++k) dst[m][k] = *(const PG8_LAS bf16x8*)(lds + PG8_SA(b, h) + aoff + m * 2048 + k * 1024); } while (0)
#define PG8_LDB(dst, b, h) do { _Pragma("unroll") for (int n = 0; n < 2; ++n) _Pragma("unroll") for (int k = 0; k < 2; ++k) dst[n][k] = *(const PG8_LAS bf16x8*)(lds + PG8_SB(b, h) + boff + n * 2048 + k * 1024); } while (0)
#define PG8_MMA(ai, bj, At, Bt) do { __builtin_amdgcn_s_setprio(1); _Pragma("unroll") for (int m = 0; m < 4; ++m) _Pragma("unroll") for (int n = 0; n < 2; ++n) _Pragma("unroll") for (int k = 0; k < 2; ++k) \
        acc[ai][bj][m][n] = __builtin_amdgcn_mfma_f32_16x16x32_bf16(Bt[n][k], At[m][k], acc[ai][bj][m][n], 0, 0, 0); __builtin_amdgcn_s_setprio(0); } while (0)
#define PG8_WAIT_V(n) asm volatile("s_waitcnt vmcnt(" #n ")" ::: "memory")
#define PG8_WAIT_L(n) asm volatile("s_waitcnt lgkmcnt(" #n ")" ::: "memory")
#define PG8_BAR __builtin_amdgcn_s_barrier()
#define PG8_SCHED __builtin_amdgcn_sched_barrier(0)
    Unit cur, nxt; int ui = 0;
    if (!S.next(0, cur)) return;
    f32x4 acc[2][2][4][2];
#pragma unroll
    for (int a = 0; a < 2; ++a)
#pragma unroll
        for (int b = 0; b < 2; ++b)
#pragma unroll
            for (int m = 0; m < 4; ++m)
#pragma unroll
                for (int n = 0; n < 2; ++n) acc[a][b][m][n] = (f32x4){0.f, 0.f, 0.f, 0.f};
    bf16x8 At[4][2], B0[2][2], B1[2][2];
    const char* cA = (const char*)g.A + (size_t)cur.pm * tstep; const char* cB = (const char*)g.Bt + (size_t)cur.pn * tstep;
    S.a_ready(cur);
    if constexpr (SP2) {
        PG8_STAGE(PG8_SB(0, 0), cB, voffB); PG8_STAGE(PG8_SB(0, 1), cB + hstep, voffB); PG8_STAGE(PG8_SA(0, 0), cA, voffA); PG8_STAGE(PG8_SA(0, 1), cA + hstep, voffA);
        if (wr == 1) PG8_BAR;
        PG8_WAIT_V(2); PG8_BAR;
        PG8_STAGE(PG8_SB(1, 0), cB + kstep, voffB); PG8_STAGE(PG8_SA(1, 0), cA + kstep, voffA); PG8_STAGE(PG8_SB(1, 1), cB + hstep + kstep, voffB);
        PG8_WAIT_V(6); PG8_BAR;
    } else {
        PG8_STAGE(PG8_SB(0, 0), cB, voffB); PG8_STAGE(PG8_SA(0, 0), cA, voffA); PG8_STAGE(PG8_SB(0, 1), cB + hstep, voffB); PG8_STAGE(PG8_SA(0, 1), cA + hstep, voffA);
        if (wr == 1) PG8_BAR;
        PG8_WAIT_V(4); PG8_BAR;
        PG8_STAGE(PG8_SB(1, 0), cB + kstep, voffB); PG8_STAGE(PG8_SA(1, 0), cA + kstep, voffA); PG8_STAGE(PG8_SB(1, 1), cB + hstep + kstep, voffB);
        PG8_WAIT_V(6); PG8_BAR;
    }
    for (;;) {
        const bool has_next = S.next(ui + 1, nxt);
        const char* nA = has_next ? (const char*)g.A + (size_t)nxt.pm * tstep : cA; const char* nB = has_next ? (const char*)g.Bt + (size_t)nxt.pn * tstep : cB;
        for (int t = 0; t < nt; t += 2) {
            const bool last = (t == nt - 2);
            const char* a1 = cA + (size_t)(t + 1) * kstep;
            const char* a2 = last ? nA : cA + (size_t)(t + 2) * kstep; const char* b2 = last ? nB : cB + (size_t)(t + 2) * kstep;
            const char* a3 = a2 + kstep; const char* b3 = b2 + kstep;
            if (last && has_next) S.a_ready(nxt);
            if constexpr (SP2) {
            PG8_LDB(B0, 0, 0); PG8_LDB(B1, 0, 1); PG8_SCHED; PG8_LDA(At, 0, 0); PG8_STAGE(PG8_SA(1, 1), a1 + hstep, voffA);
            PG8_WAIT_V(8); PG8_WAIT_L(0); PG8_BAR; PG8_MMA(0, 0, At, B0); PG8_MMA(0, 1, At, B1); PG8_BAR; PG8_SCHED;
            PG8_LDA(At, 0, 1); PG8_STAGE(PG8_SB(0, 0), b2, voffB); PG8_STAGE(PG8_SB(0, 1), b2 + hstep, voffB); PG8_STAGE(PG8_SA(0, 0), a2, voffA);
            PG8_WAIT_V(8); PG8_WAIT_L(0); PG8_BAR; PG8_MMA(1, 0, At, B0); PG8_MMA(1, 1, At, B1); PG8_BAR; PG8_SCHED;
            PG8_LDB(B0, 1, 0); PG8_LDB(B1, 1, 1); PG8_SCHED; PG8_LDA(At, 1, 0); PG8_STAGE(PG8_SA(0, 1), a2 + hstep, voffA);
            PG8_WAIT_V(8); PG8_WAIT_L(0); PG8_BAR; PG8_MMA(0, 0, At, B0); PG8_MMA(0, 1, At, B1); PG8_BAR; PG8_SCHED;
            PG8_LDA(At, 1, 1); PG8_STAGE(PG8_SB(1, 0), b3, voffB); PG8_STAGE(PG8_SB(1, 1), b3 + hstep, voffB); PG8_STAGE(PG8_SA(1, 0), a3, voffA);
            PG8_WAIT_V(8); PG8_WAIT_L(0); PG8_BAR; PG8_MMA(1, 0, At, B0); PG8_MMA(1, 1, At, B1); PG8_BAR; PG8_SCHED;
            } else {
            PG8_LDB(B0, 0, 0); PG8_SCHED; PG8_LDA(At, 0, 0); PG8_STAGE(PG8_SA(1, 1), a1 + hstep, voffA);
            PG8_WAIT_L(8); PG8_BAR; PG8_WAIT_L(0); PG8_MMA(0, 0, At, B0); PG8_BAR; PG8_SCHED;
            PG8_LDB(B1, 0, 1); PG8_STAGE(PG8_SB(0, 0), b2, voffB);
            PG8_BAR; PG8_WAIT_L(0); PG8_MMA(0, 1, At, B1); PG8_BAR;
            PG8_LDA(At, 0, 1); PG8_STAGE(PG8_SA(0, 0), a2, voffA);
            PG8_BAR; PG8_WAIT_L(0); PG8_MMA(1, 0, At, B0); PG8_BAR; PG8_SCHED;
            PG8_STAGE(PG8_SB(0, 1), b2 + hstep, voffB);
            PG8_WAIT_V(6); PG8_BAR; PG8_MMA(1, 1, At, B1); PG8_BAR;
            PG8_LDB(B0, 1, 0); PG8_SCHED; PG8_LDA(At, 1, 0); PG8_STAGE(PG8_SA(0, 1), a2 + hstep, voffA);
            PG8_WAIT_L(8); PG8_BAR; PG8_WAIT_L(0); PG8_MMA(0, 0, At, B0); PG8_BAR; PG8_SCHED;
            PG8_LDB(B1, 1, 1); PG8_STAGE(PG8_SB(1, 0), b3, voffB);
            PG8_BAR; PG8_WAIT_L(0); PG8_MMA(0, 1, At, B1); PG8_BAR;
            PG8_LDA(At, 1, 1); PG8_STAGE(PG8_SA(1, 0), a3, voffA);
            PG8_BAR; PG8_WAIT_L(0); PG8_MMA(1, 0, At, B0); PG8_BAR; PG8_SCHED;
            PG8_STAGE(PG8_SB(1, 1), b3 + hstep, voffB);
            PG8_WAIT_V(6); PG8_BAR; PG8_MMA(1, 1, At, B1); PG8_BAR;
            }
        }
        if constexpr (ALIGN_EPI) { if (wr == 0) PG8_BAR; }
        if constexpr (!Epi::AFTER_DRAIN) { E(acc, cur, wr, wc, fr, fq); S.done(cur); }
        if (!has_next) break;
#pragma unroll
        for (int a = 0; a < 2; ++a)
#pragma unroll
            for (int b = 0; b < 2; ++b)
#pragma unroll
                for (int m = 0; m < 4; ++m)
#pragma unroll
                    for (int n = 0; n < 2; ++n) acc[a][b][m][n] = (f32x4){0.f, 0.f, 0.f, 0.f};
        cur = nxt; cA = nA; cB = nB; ++ui;
        if constexpr (ALIGN_EPI) { if (wr == 1) PG8_BAR; }
    }
    PG8_WAIT_V(0);
    if constexpr (!ALIGN_EPI) { if (wr == 0) PG8_BAR; }
    PG8_BAR;
    if constexpr (Epi::AFTER_DRAIN) { E.fused(acc, cur, wr, wc, fr, fq, lds, wid, lane); S.done(cur); }
#undef PG8_SA
#undef PG8_SB
#undef PG8_STAGE
#undef PG8_LDA
#undef PG8_LDB
#undef PG8_MMA
#undef PG8_WAIT_V
#undef PG8_WAIT_L
#undef PG8_BAR
#undef PG8_SCHED
}
}

#define GAS __attribute__((address_space(1)))
#define LAS __attribute__((address_space(3)))
typedef unsigned short bf16_t;
typedef unsigned v4u __attribute__((ext_vector_type(4)));
typedef float f32x4 __attribute__((ext_vector_type(4)));
typedef unsigned u32x4 __attribute__((ext_vector_type(4)));
#define LDS_WAIT() asm volatile("s_waitcnt lgkmcnt(0)" ::: "memory")
__device__ __forceinline__ unsigned f2bf(float f) { unsigned u = __builtin_bit_cast(unsigned, f); return (u + 0x7fffu + ((u >> 16) & 1u)) >> 16; }
__device__ __forceinline__ unsigned pk2(float lo, float hi) { return f2bf(lo) | (f2bf(hi) << 16); }
__device__ __forceinline__ float bf2f(bf16_t v) { return __uint_as_float(((unsigned)v) << 16); }
__device__ __forceinline__ float wave_sum(float v) {
#pragma unroll
    for (int o = 1; o < 64; o <<= 1) v += __shfl_xor(v, o);
    return v;
}
constexpr int NWAVES = 8;
constexpr int RING_OFF = 0, RING_BYTES = 131072;
constexpr int LDSCTL_OFF = RING_BYTES, MISC_OFF = LDSCTL_OFF + 320;
constexpr int LDS_BYTES = 147456;

#define XB_TMO      128
#define XB_XCNT(j)  (256  + 64 * (j))
#define XB_XSUB(j)  (1280 + 64 * (j))
#define XB_XGEN(j)  (2304 + 64 * (j))
#define XB_TOP      3328
#define XB_TOPGEN   3392
#define XCD_BAR_WORDS 3456
#define XB_SPIN_CAP (1u << 18)

__device__ __forceinline__ unsigned xb_ld(unsigned* p)              { return __hip_atomic_load(p, __ATOMIC_RELAXED, __HIP_MEMORY_SCOPE_AGENT); }
__device__ __forceinline__ unsigned xb_add(unsigned* p, unsigned v) { return __hip_atomic_fetch_add(p, v, __ATOMIC_RELAXED, __HIP_MEMORY_SCOPE_AGENT); }
__device__ __forceinline__ unsigned xb_xcc_id() { return (unsigned)__builtin_amdgcn_s_getreg((3 << 11) | 20) & 0xFu; }
#define XB_SPIN(cond, bar) do { unsigned _sp = 0; while (cond) { __builtin_amdgcn_s_sleep(1); \
    if ((++_sp & 255u) == 0u) { if (xb_ld(&(bar)[XB_TMO])) break; if (_sp > XB_SPIN_CAP) { atomicAdd(&(bar)[XB_TMO], 1u); break; } } } } while (0)

struct XcdBarrier {
    unsigned* bar; unsigned x;
    volatile LAS unsigned* st;
};

__device__ __forceinline__ XcdBarrier xcd_barrier_post(unsigned* bar, volatile LAS unsigned* st) {
    XcdBarrier b; b.bar = bar; b.x = xb_xcc_id(); b.st = st;
    if (threadIdx.x == 0) (void)xb_add(&bar[XB_XCNT(b.x)], 1u);
    return b;
}
__device__ __forceinline__ void xcd_barrier_complete(unsigned* bar, unsigned x, unsigned& nloc, unsigned& nx) {
    const unsigned G = gridDim.x * gridDim.y * gridDim.z;
    unsigned sum, cnt, mine, sp = 0u;
    for (;;) {
        sum = 0u; cnt = 0u; mine = 0u;
#pragma unroll
        for (unsigned j = 0; j < 16; ++j) { const unsigned c = xb_ld(&bar[XB_XCNT(j)]); sum += c; cnt += (c > 0u) ? 1u : 0u; mine = (j == x) ? c : mine; }
        if (sum == G) break;
        __builtin_amdgcn_s_sleep(1);
        if ((++sp & 255u) == 0u) { if (xb_ld(&bar[XB_TMO])) break; if (sp > XB_SPIN_CAP) { atomicAdd(&bar[XB_TMO], 1u); break; } }
    }
    nloc = mine > 0u ? mine : 1u; nx = cnt > 0u ? cnt : 1u;
}

__device__ __forceinline__ void xcd_barrier(const XcdBarrier& b) {
    asm volatile("s_waitcnt vmcnt(0)" ::: "memory");
    __syncthreads();
    if (threadIdx.x == 0) {
        unsigned* bar = b.bar;
        __builtin_amdgcn_s_waitcnt(0);
        unsigned nloc = b.st[0], nx = b.st[1];
        if (nloc == 0u) { xcd_barrier_complete(bar, b.x, nloc, nx); b.st[0] = nloc; b.st[1] = nx; }
        const unsigned old = xb_add(&bar[XB_XSUB(b.x)], 1u);
        const unsigned gen = old / nloc;
        if (old + 1u == (gen + 1u) * nloc) {
            __builtin_amdgcn_fence(__ATOMIC_RELEASE, "agent");
            asm volatile("s_waitcnt vmcnt(0)" ::: "memory");
            const unsigned og = xb_add(&bar[XB_TOP], 1u);
            const unsigned tg = og / nx;
            if (og + 1u == (tg + 1u) * nx) xb_add(&bar[XB_TOPGEN], 1u);
            else XB_SPIN(xb_ld(&bar[XB_TOPGEN]) == tg, bar);
            __builtin_amdgcn_fence(__ATOMIC_ACQUIRE, "agent");
            xb_add(&bar[XB_XGEN(b.x)], 1u);
            asm volatile("s_waitcnt vmcnt(0)" ::: "memory");
        } else {
            XB_SPIN(xb_ld(&bar[XB_XGEN(b.x)]) == gen, bar);
            __builtin_amdgcn_fence(__ATOMIC_ACQUIRE, "agent");
            asm volatile("s_waitcnt vmcnt(0)" ::: "memory");
        }
    }
    __syncthreads();
}

struct Frame {
    LAS unsigned char* lds; volatile LAS unsigned* MISC;
    int tid, lane, wave, vcu, G;
    unsigned char* ws; unsigned char* dout;
    const float *x, *mem, *norm_w, *mem_norm_w, *w_in, *b_merge, *w_mem_kv, *w_a, *w_b, *w_m, *w_out, *final_w;
};
__device__ __forceinline__ void p0_transpose_item(const float* W, int K, int N, bf16_t* WT, LAS float* scr, int item, int lane) {
    const int nblk = N / 32, kb = item / nblk, nb = item % nblk, k0 = 64 * kb, n0 = 32 * nb;
#pragma unroll 8
    for (int i = 0; i < 32; ++i) { const int kk = 2 * i + (lane >> 5); scr[kk * 33 + (lane & 31)] = W[(size_t)(k0 + kk) * N + n0 + (lane & 31)]; }
    LDS_WAIT(); asm volatile("" ::: "memory");
    const int c = lane & 7;
#pragma unroll
    for (int j = 0; j < 4; ++j) { const int n = (lane >> 3) + 8 * j; const LAS float* s = scr + (8 * c) * 33 + n;
        v4u o; o.x = pk2(s[0 * 33], s[1 * 33]); o.y = pk2(s[2 * 33], s[3 * 33]); o.z = pk2(s[4 * 33], s[5 * 33]); o.w = pk2(s[6 * 33], s[7 * 33]);
        *(GAS v4u*)(WT + (size_t)(n0 + n) * K + k0 + 8 * c) = o; }
    LDS_WAIT(); asm volatile("" ::: "memory");
}
__device__ __forceinline__ void rms_row_to_bf16(int lane, const float* xrow, const float* w, bf16_t* orow) {
    const GAS f32x4* xr = (const GAS f32x4*)xrow + lane;
    f32x4 v[4]; float s = 0.f;
#pragma unroll
    for (int j = 0; j < 4; ++j) { v[j] = xr[64 * j]; s += (v[j].x * v[j].x + v[j].y * v[j].y) + (v[j].z * v[j].z + v[j].w * v[j].w); }
    const float rs = 1.f / sqrtf(wave_sum(s) * (1.f / D) + EPS);
    GAS unsigned long long* o8 = (GAS unsigned long long*)orow + lane;
#pragma unroll
    for (int j = 0; j < 4; ++j) { const f32x4 ww = ((const GAS f32x4*)w)[lane + 64 * j];
        o8[64 * j] = (unsigned long long)pk2(v[j].x * rs * ww.x, v[j].y * rs * ww.y) | ((unsigned long long)pk2(v[j].z * rs * ww.z, v[j].w * rs * ww.w) << 32); }
}
__device__ __forceinline__ void p0_prologue(Frame& F) {
    LAS float* scr = (LAS float*)(F.lds + RING_OFF + F.wave * 16384);
    const int gw = F.vcu * NWAVES + F.wave, NGW = F.G * NWAVES;
    constexpr int I_IN = (1024 / 64) * (DIN / 32), I_A = (512 / 64) * (1024 / 32), I_B = I_A, I_M = (256 / 64) * (1024 / 32), I_O = (1024 / 64) * (1024 / 32);
    constexpr int NITEMS = I_IN + I_A + I_B + I_M + I_O;
    for (int it = gw; it < NITEMS; it += NGW) {
        int r = it;
        if (r < I_IN) { p0_transpose_item(F.w_in, 1024, DIN, (bf16_t*)(F.ws + WS_WIN), scr, r, F.lane); continue; } r -= I_IN;
        if (r < I_A) { p0_transpose_item(F.w_a, 512, 1024, (bf16_t*)(F.ws + WS_WA), scr, r, F.lane); continue; } r -= I_A;
        if (r < I_B) { p0_transpose_item(F.w_b, 512, 1024, (bf16_t*)(F.ws + WS_WB), scr, r, F.lane); continue; } r -= I_B;
        if (r < I_M) { p0_transpose_item(F.w_m, 256, 1024, (bf16_t*)(F.ws + WS_WM), scr, r, F.lane); continue; } r -= I_M;
        p0_transpose_item(F.w_out, 1024, 1024, (bf16_t*)(F.ws + WS_WO), scr, r, F.lane);
    }
    bf16_t* XN = (bf16_t*)(F.ws + WS_XN);
    for (int m = gw; m < M; m += NGW) rms_row_to_bf16(F.lane, F.x + (size_t)m * D, F.norm_w, XN + (size_t)m * D);
    bf16_t* KM = (bf16_t*)(F.ws + WS_KM); bf16_t* VM = (bf16_t*)(F.ws + WS_VM);
    for (int idx = F.vcu * 512 + F.tid; idx < 512 * 512; idx += F.G * 512) {
        const int r = idx >> 9, n = idx & 511; const float* mr = F.mem + (size_t)r * D;
        float ss = 0.f, acc = 0.f;
        for (int k = 0; k < D; ++k) { const float a = mr[k]; ss += a * a; acc += a * F.mem_norm_w[k] * F.w_mem_kv[(size_t)k * 512 + n]; }
        const float v = acc * (1.0f / sqrtf(ss * (1.f / D) + EPS));
        if (n < 256) KM[(size_t)r * 256 + n] = (bf16_t)f2bf(v); else VM[(size_t)r * 256 + (n - 256)] = (bf16_t)f2bf(v);
    }
}

__device__ __forceinline__ float bf_lo(unsigned w) { return __uint_as_float(w << 16); }
__device__ __forceinline__ float bf_hi(unsigned w) { return __uint_as_float(w & 0xffff0000u); }
typedef short bf16x8 __attribute__((ext_vector_type(8)));
typedef short s16x4 __attribute__((ext_vector_type(4)));
typedef short v4i16_t __attribute__((ext_vector_type(4)));
#define DI __device__ __forceinline__
#define MFMA32(a, b, c) __builtin_amdgcn_mfma_f32_32x32x16_bf16((a), (b), (c), 0, 0, 0)
constexpr float NEGBIG = -1e30f;
constexpr int CW_CNT = 8192;
constexpr size_t WS_LSEA = 4 * MiB;
constexpr size_t WS_PL = 7 * MiB;
constexpr size_t WS_KMB = 10 * MiB;
DI int crow(int r, int hi) { return (r & 3) + 8 * (r >> 2) + 4 * hi; }
DI unsigned cvtpk(float lo, float hi) { typedef float f2_t __attribute__((ext_vector_type(2))); typedef __bf16 b2_t __attribute__((ext_vector_type(2))); f2_t v = {lo, hi}; b2_t b = __builtin_convertvector(v, b2_t); return __builtin_bit_cast(unsigned, b); }
DI s16x4 vtr(LAS const unsigned char* p) { return __builtin_bit_cast(s16x4, __builtin_amdgcn_ds_read_tr16_b64_v4i16((LAS v4i16_t*)p)); }
DI void dma16(const void* gsrc, LAS unsigned char* ldst) { __builtin_amdgcn_global_load_lds((const unsigned*)gsrc, (LAS unsigned*)ldst, 16, 0, 0); }
DI void dma_k_piece(const bf16_t* rowp, int lane, LAS unsigned char* tile, int sub) { dma16(rowp + (2 * sub + (lane >> 5)) * 8, tile + sub * 1024); }
DI void dma_v_piece(const bf16_t* rowp, int lane, LAS unsigned char* tile, int sub) { dma16(rowp + (sub >> 1) * 32 + (lane & 3) * 8, tile + sub * 1024); }

template <int NT, bool MF, bool ML>
DI void attn_chunk(const bf16x8 (&qr)[4], LAS const unsigned char* kp, LAS const unsigned char* vp, const float (&ck)[16], float cq0, float ctile, int skip_lt, int r32, int hi,
                   float& m_run, float& l_run, f32x16& o0, f32x16& o1) {
    f32x16 s[NT];
#pragma unroll
    for (int tt = 0; tt < NT; ++tt) {
        const float cq = cq0 + ctile * (float)tt;
#pragma unroll
        for (int r = 0; r < 16; ++r) s[tt][r] = ck[r] + cq;
#pragma unroll
        for (int d0 = 0; d0 < 4; ++d0) { const bf16x8 kf = *(LAS const bf16x8*)(kp + tt * 4096 + d0 * 1024); s[tt] = MFMA32(kf, qr[d0], s[tt]); }
        if (MF && tt == 0) {
#pragma unroll
            for (int r = 0; r < 16; ++r) if (crow(r, hi) < r32) s[tt][r] = NEGBIG; }
        if (ML && tt == NT - 1) {
#pragma unroll
            for (int r = 0; r < 16; ++r) if (crow(r, hi) > r32) s[tt][r] = NEGBIG; }
        if (tt < skip_lt) {
#pragma unroll
            for (int r = 0; r < 16; ++r) s[tt][r] = NEGBIG; }
    }
    float mx = s[0][0];
#pragma unroll
    for (int tt = 0; tt < NT; ++tt)
#pragma unroll
        for (int r = 0; r < 16; ++r) mx = fmaxf(mx, s[tt][r]);
    mx = fmaxf(mx, __shfl_xor(mx, 32));
    const float m_new = fmaxf(m_run, mx), f = __builtin_amdgcn_exp2f(m_run - m_new);
    m_run = m_new; l_run *= f; o0 = o0 * f; o1 = o1 * f;
    float ls = 0.f;
#pragma unroll
    for (int tt = 0; tt < NT; ++tt)
#pragma unroll
        for (int r = 0; r < 16; ++r) { s[tt][r] = __builtin_amdgcn_exp2f(s[tt][r] - m_new); ls += s[tt][r]; }
    l_run += ls;
#pragma unroll
    for (int tt = 0; tt < NT; ++tt)
#pragma unroll
        for (int si = 0; si < 2; ++si) {
            u32x4 pw; pw.x = cvtpk(s[tt][8 * si + 0], s[tt][8 * si + 1]); pw.y = cvtpk(s[tt][8 * si + 2], s[tt][8 * si + 3]); pw.z = cvtpk(s[tt][8 * si + 4], s[tt][8 * si + 5]); pw.w = cvtpk(s[tt][8 * si + 6], s[tt][8 * si + 7]);
            const bf16x8 pb = __builtin_bit_cast(bf16x8, pw);
            { const s16x4 lo = vtr(vp + tt * 4096 + si * 1024), hi4 = vtr(vp + tt * 4096 + si * 1024 + 512);
              const bf16x8 vf = (bf16x8){lo[0], lo[1], lo[2], lo[3], hi4[0], hi4[1], hi4[2], hi4[3]}; o0 = MFMA32(vf, pb, o0); }
            { const s16x4 lo = vtr(vp + tt * 4096 + 2048 + si * 1024), hi4 = vtr(vp + tt * 4096 + 2048 + si * 1024 + 512);
              const bf16x8 vf = (bf16x8){lo[0], lo[1], lo[2], lo[3], hi4[0], hi4[1], hi4[2], hi4[3]}; o1 = MFMA32(vf, pb, o1); }
        }
}
DI int v_lanepart(int lane) { return ((lane >> 4) & 1) * 32 + (lane & 3) * 8 + (4 * (lane >> 5) + ((lane & 15) >> 2)) * 64; }

DI void mixA_phase(Frame& F) {
    int lane_ = F.lane; asm volatile("" : "+v"(lane_)); const int lane = lane_, r32 = lane & 31, hi = lane >> 5, w = F.wave;
    LAS unsigned char* ldsK = F.lds; LAS unsigned char* ldsV = F.lds + 49152;
    unsigned char* R1 = F.ws + WS_R1; float* LSEA = (float*)(F.ws + WS_LSEA);
    for (int u = F.vcu; u < 3072; u += F.G) {
        const int g = u >> 10, rem = u & 1023, bh = rem >> 6, xx = rem & 63, b = bh >> 3, h = bh & 7;
        const int sh = 2 * g, dil = 1 << sh, cls = xx >> (6 - sh), p = xx & ((64 >> sh) - 1);
        bf16_t* Qp = (bf16_t*)(R1 + (size_t)slot_q(g) * SLOT) + (size_t)b * S * 512 + h * 64;
        const bf16_t* Kp = (const bf16_t*)(R1 + (size_t)slot_k(g) * SLOT) + (size_t)b * S * 512 + h * 64;
        const bf16_t* Vp = (const bf16_t*)(R1 + (size_t)slot_v(g) * SLOT) + (size_t)b * S * 512 + h * 64;
        const int i0 = 256 * p - 128;
        {
            int ik = i0 + 32 * w + (lane & 31); ik = ik < 0 ? 0 : ik; const bf16_t* krow = Kp + (size_t)(ik * dil + cls) * 512;
#pragma unroll
            for (int sub = 0; sub < 4; ++sub) dma_k_piece(krow, lane, ldsK + w * 4096, sub);
#pragma unroll
            for (int kh = 0; kh < 2; ++kh) { int iv = i0 + 32 * w + 16 * kh + (lane >> 2); iv = iv < 0 ? 0 : iv; const bf16_t* vrow = Vp + (size_t)(iv * dil + cls) * 512;
                dma_v_piece(vrow, lane, ldsV + w * 4096, kh); dma_v_piece(vrow, lane, ldsV + w * 4096, 2 + kh); }
            const int t2 = 8 + (w >> 1);
            if ((w & 1) == 0) { const bf16_t* kr2 = Kp + (size_t)((i0 + 32 * t2 + (lane & 31)) * dil + cls) * 512;
#pragma unroll
                for (int sub = 0; sub < 4; ++sub) dma_k_piece(kr2, lane, ldsK + t2 * 4096, sub); }
            else {
#pragma unroll
                for (int kh = 0; kh < 2; ++kh) { const bf16_t* vr2 = Vp + (size_t)((i0 + 32 * t2 + 16 * kh + (lane >> 2)) * dil + cls) * 512;
                    dma_v_piece(vr2, lane, ldsV + t2 * 4096, kh); dma_v_piece(vr2, lane, ldsV + t2 * 4096, 2 + kh); } }
        }
        const int qi = 256 * p + 32 * w + r32; const size_t qrow = (size_t)(qi * dil + cls) * 512;
        bf16x8 qr[4];
#pragma unroll
        for (int d0 = 0; d0 < 4; ++d0) qr[d0] = *(const bf16x8*)(Qp + qrow + d0 * 16 + hi * 8);
        const float cb = __builtin_amdgcn_exp2f(-(float)h - 0.5f) * LOG2E * (float)dil;
        float ck[16];
#pragma unroll
        for (int r = 0; r < 16; ++r) ck[r] = cb * (float)crow(r, hi);
        asm volatile("s_waitcnt vmcnt(0)" ::: "memory"); __syncthreads();
        float m_run = NEGBIG, l_run = 0.f; f32x16 o0, o1;
#pragma unroll
        for (int r = 0; r < 16; ++r) { o0[r] = 0.f; o1[r] = 0.f; }
        const int skip_lt = (p == 0 && w < 4) ? (4 - w) : 0;
        attn_chunk<5, true, true>(qr, ldsK + w * 4096 + hi * 512 + r32 * 16, ldsV + w * 4096 + v_lanepart(lane), ck, -cb * (float)(128 + r32), cb * 32.f, skip_lt, r32, hi, m_run, l_run, o0, o1);
        const float l = l_run + __shfl_xor(l_run, 32), inv = __builtin_amdgcn_rcpf(l);
#pragma unroll
        for (int gg = 0; gg < 4; ++gg) {
            u32x2 a; a.x = cvtpk(o0[4 * gg] * inv, o0[4 * gg + 1] * inv); a.y = cvtpk(o0[4 * gg + 2] * inv, o0[4 * gg + 3] * inv);
            u32x2 c; c.x = cvtpk(o1[4 * gg] * inv, o1[4 * gg + 1] * inv); c.y = cvtpk(o1[4 * gg + 2] * inv, o1[4 * gg + 3] * inv);
            *(u32x2*)(Qp + qrow + 8 * gg + 4 * hi) = a; *(u32x2*)(Qp + qrow + 32 + 8 * gg + 4 * hi) = c;
        }
        if (hi == 0) LSEA[((size_t)g * M + (size_t)b * S + qi * dil + cls) * 8 + h] = m_run + __builtin_amdgcn_logf(l);
        __syncthreads();
    }
}
DI void memattn_phase(Frame& F) {
    int lane_ = F.lane; asm volatile("" : "+v"(lane_)); const int lane = lane_, r32 = lane & 31, hi = lane >> 5, w = F.wave;
    LAS unsigned char* ldsK = F.lds; LAS unsigned char* ldsV = F.lds + 32768;
    const bf16_t* MQ = (const bf16_t*)(F.ws + WS_MQ); bf16_t* MG = (bf16_t*)(F.ws + WS_MG);
    const bf16_t* KM = (const bf16_t*)(F.ws + WS_KM); const bf16_t* VM = (const bf16_t*)(F.ws + WS_VM);
    for (int u = F.vcu; u < 512; u += F.G) {
        const int b = u >> 8, hm = (u >> 6) & 3, qt = u & 63;
        {
            const bf16_t* krow = KM + (size_t)(b * 256 + 32 * w + (lane & 31)) * 256 + hm * 64;
            const bf16_t* vrow = VM + (size_t)(b * 256 + 32 * w + (lane >> 2)) * 256 + hm * 64;
#pragma unroll
            for (int sub = 0; sub < 4; ++sub) { dma_k_piece(krow, lane, ldsK + w * 4096, sub); dma_v_piece(vrow + (size_t)(16 * (sub & 1)) * 256, lane, ldsV + w * 4096, sub); }
        }
        const size_t qrow = ((size_t)b * S + 256 * qt + 32 * w + r32) * 256 + hm * 64;
        bf16x8 qr[4];
#pragma unroll
        for (int d0 = 0; d0 < 4; ++d0) qr[d0] = *(const bf16x8*)(MQ + qrow + d0 * 16 + hi * 8);
        float ck[16];
#pragma unroll
        for (int r = 0; r < 16; ++r) ck[r] = 0.f;
        asm volatile("s_waitcnt vmcnt(0)" ::: "memory"); __syncthreads();
        float m_run = NEGBIG, l_run = 0.f; f32x16 o0, o1;
#pragma unroll
        for (int r = 0; r < 16; ++r) { o0[r] = 0.f; o1[r] = 0.f; }
#pragma unroll 1
        for (int c = 0; c < 2; ++c)
            attn_chunk<4, false, false>(qr, ldsK + c * 16384 + hi * 512 + r32 * 16, ldsV + c * 16384 + v_lanepart(lane), ck, 0.f, 0.f, 0, r32, hi, m_run, l_run, o0, o1);
        const float l = l_run + __shfl_xor(l_run, 32), inv = __builtin_amdgcn_rcpf(l);
#pragma unroll
        for (int gg = 0; gg < 4; ++gg) {
            bf16_t* p0 = MG + qrow + 8 * gg + 4 * hi; bf16_t* p1 = p0 + 32;
            const u32x2 g0 = *(const u32x2*)p0, g1 = *(const u32x2*)p1;
            u32x2 a; a.x = cvtpk(o0[4 * gg] * inv * bf_lo(g0.x), o0[4 * gg + 1] * inv * bf_hi(g0.x)); a.y = cvtpk(o0[4 * gg + 2] * inv * bf_lo(g0.y), o0[4 * gg + 3] * inv * bf_hi(g0.y));
            u32x2 c; c.x = cvtpk(o1[4 * gg] * inv * bf_lo(g1.x), o1[4 * gg + 1] * inv * bf_hi(g1.x)); c.y = cvtpk(o1[4 * gg + 2] * inv * bf_lo(g1.y), o1[4 * gg + 3] * inv * bf_hi(g1.y));
            *(u32x2*)p0 = a; *(u32x2*)p1 = c;
        }
        __syncthreads();
    }
}

DI void kmean_phase(Frame& F) {
    int lane_ = F.lane; asm volatile("" : "+v"(lane_)); const int lane = lane_, w = F.wave;
    const bf16_t* BK = (const bf16_t*)(F.dout + 1 * SLOT); bf16_t* KMB = (bf16_t*)(F.ws + WS_KMB);
    LAS float* part = (LAS float*)(F.lds);
    for (int u = F.vcu; u < 1024; u += F.G) {
        const int bh = u >> 6, n = u & 63, b = bh >> 3, h = bh & 7;
        const bf16_t* p = BK + ((size_t)b * S + 256 * n + 32 * w) * 512 + h * 64 + lane;
        float s = 0.f;
#pragma unroll 8
        for (int r = 0; r < 32; ++r) s += bf2f(p[(size_t)r * 512]);
        part[w * 64 + lane] = s;
        __syncthreads();
        if (w == 0) { float t = 0.f;
#pragma unroll
            for (int i = 0; i < 8; ++i) t += part[i * 64 + lane];
            KMB[(size_t)u * 64 + lane] = (bf16_t)f2bf(t * (1.f / 256.f)); }
        __syncthreads();
    }
}
#define TOP3_INS(val, idx) do { const float v_ = (val); const int i_ = (idx); \
    if (v_ > v0) { v2 = v1; i2 = i1; v1 = v0; i1 = i0; v0 = v_; i0 = i_; } else if (v_ > v1) { v2 = v1; i2 = i1; v1 = v_; i1 = i_; } else if (v_ > v2) { v2 = v_; i2 = i_; } } while (0)
#define BETTER(va, ia, vb, ib) ((va) > (vb) || ((va) == (vb) && (ia) < (ib)))
#define TOP3_INS_TIE(val, idx) do { const float v_ = (val); const int i_ = (idx); \
    if (BETTER(v_, i_, v0, i0)) { v2 = v1; i2 = i1; v1 = v0; i1 = i0; v0 = v_; i0 = i_; } else if (BETTER(v_, i_, v1, i1)) { v2 = v1; i2 = i1; v1 = v_; i1 = i_; } else if (BETTER(v_, i_, v2, i2)) { v2 = v_; i2 = i_; } } while (0)
DI void select_phase(Frame& F) {
    int lane_ = F.lane; asm volatile("" : "+v"(lane_)); const int lane = lane_, r32 = lane & 31, hi = lane >> 5, w = F.wave;
    LAS unsigned char* ldsK = F.lds; LAS unsigned* hist = (LAS unsigned*)(F.lds + 8192); LAS unsigned* basev = hist + 64;
    const bf16_t* BQ = (const bf16_t*)(F.dout); const bf16_t* KMB = (const bf16_t*)(F.ws + WS_KMB);
    unsigned* cnt = (unsigned*)(F.ws + WS_CTL) + CW_CNT; unsigned short* list = (unsigned short*)(F.ws + WS_LIST);
    for (int u = F.vcu; u < 1008; u += F.G) {
        const int bh = u / 63, qb = 1 + u % 63, b = bh >> 3, h = bh & 7;
        dma_k_piece(KMB + (size_t)(bh * 64 + 32 * (w >> 2) + (lane & 31)) * 64, lane, ldsK + (w >> 2) * 4096, w & 3);
        if (F.tid < 64) hist[F.tid] = 0u;
        const int t = 256 * qb + 32 * w + r32; const size_t qrow = ((size_t)b * S + t) * 512 + h * 64;
        bf16x8 qr[4];
#pragma unroll
        for (int d0 = 0; d0 < 4; ++d0) qr[d0] = *(const bf16x8*)(BQ + qrow + d0 * 16 + hi * 8);
        asm volatile("s_waitcnt vmcnt(0)" ::: "memory"); __syncthreads();
        f32x16 s0, s1;
#pragma unroll
        for (int r = 0; r < 16; ++r) { s0[r] = 0.f; s1[r] = 0.f; }
        LAS const unsigned char* kp = ldsK + hi * 512 + r32 * 16;
#pragma unroll
        for (int d0 = 0; d0 < 4; ++d0) { const bf16x8 k0 = *(LAS const bf16x8*)(kp + d0 * 1024), k1 = *(LAS const bf16x8*)(kp + 4096 + d0 * 1024); s0 = MFMA32(k0, qr[d0], s0); s1 = MFMA32(k1, qr[d0], s1); }
        float v0 = -INFINITY, v1 = -INFINITY, v2 = -INFINITY; int i0 = -1, i1 = -1, i2 = -1;
#pragma unroll
        for (int r = 0; r < 16; ++r) { const int n = crow(r, hi); TOP3_INS(n < qb ? s0[r] : -INFINITY, n); }
#pragma unroll
        for (int r = 0; r < 16; ++r) { const int n = 32 + crow(r, hi); TOP3_INS(n < qb ? s1[r] : -INFINITY, n); }
        { const float pv0 = __shfl_xor(v0, 32), pv1 = __shfl_xor(v1, 32), pv2 = __shfl_xor(v2, 32); const int pi0 = __shfl_xor(i0, 32), pi1 = __shfl_xor(i1, 32), pi2 = __shfl_xor(i2, 32);
          TOP3_INS_TIE(pv0, pi0); TOP3_INS_TIE(pv1, pi1); TOP3_INS_TIE(pv2, pi2); }
        const int nsel = qb < 3 ? qb : 3;
        unsigned pos0 = 0, pos1 = 0, pos2 = 0;
        if (hi == 0) { pos0 = __hip_atomic_fetch_add(hist + i0, 1u, __ATOMIC_RELAXED, __HIP_MEMORY_SCOPE_WORKGROUP);
            if (nsel > 1) pos1 = __hip_atomic_fetch_add(hist + i1, 1u, __ATOMIC_RELAXED, __HIP_MEMORY_SCOPE_WORKGROUP);
            if (nsel > 2) pos2 = __hip_atomic_fetch_add(hist + i2, 1u, __ATOMIC_RELAXED, __HIP_MEMORY_SCOPE_WORKGROUP); }
        __syncthreads();
        if (F.tid < 64) { const unsigned c = hist[F.tid]; basev[F.tid] = c ? __hip_atomic_fetch_add(cnt + bh * 64 + F.tid, c, __ATOMIC_RELAXED, __HIP_MEMORY_SCOPE_AGENT) : 0u; }
        __syncthreads();
        if (hi == 0) { list[(size_t)(bh * 64 + i0) * 16384 + basev[i0] + pos0] = (unsigned short)t;
            if (nsel > 1) list[(size_t)(bh * 64 + i1) * 16384 + basev[i1] + pos1] = (unsigned short)(t | (1 << 14));
            if (nsel > 2) list[(size_t)(bh * 64 + i2) * 16384 + basev[i2] + pos2] = (unsigned short)(t | (2 << 14)); }
        __syncthreads();
    }
}
DI void moba_sel_phase(Frame& F) {
    int lane_ = F.lane; asm volatile("" : "+v"(lane_)); const int lane = lane_, r32 = lane & 31, hi = lane >> 5, w = F.wave;
    LAS unsigned char* ldsK = F.lds; LAS unsigned char* ldsV = F.lds + 32768;
    LAS unsigned* pre = (LAS unsigned*)(F.lds + 65536); LAS unsigned* wtot = pre + 1100; LAS unsigned* cl = pre + 1280;
    const unsigned* cnt = (const unsigned*)(F.ws + WS_CTL) + CW_CNT; const unsigned short* list = (const unsigned short*)(F.ws + WS_LIST);
    const bf16_t* BQ = (const bf16_t*)(F.dout); const bf16_t* BK = (const bf16_t*)(F.dout + 1 * SLOT); const bf16_t* BV = (const bf16_t*)(F.dout + 2 * SLOT);
    unsigned char* R1 = F.ws + WS_R1; float* PL = (float*)(F.ws + WS_PL);
    {
        const unsigned c0 = cnt[2 * F.tid], c1 = cnt[2 * F.tid + 1], n0 = (c0 + 255u) >> 8, n1 = (c1 + 255u) >> 8, sum = n0 + n1;
        cl[2 * F.tid] = c0; cl[2 * F.tid + 1] = c1;
        unsigned x = sum;
#pragma unroll
        for (int o = 1; o < 64; o <<= 1) { const unsigned y = __shfl_up(x, o); if (lane >= o) x += y; }
        if (lane == 63) wtot[w] = x;
        __syncthreads();
        unsigned woff = 0;
        for (int i = 0; i < w; ++i) woff += wtot[i];
        const unsigned excl = woff + x - sum;
        pre[2 * F.tid] = excl; pre[2 * F.tid + 1] = excl + n0; if (F.tid == 511) pre[1024] = excl + sum;
        __syncthreads();
    }
    const int total = (int)pre[1024];
    for (int c = F.vcu; c < total; c += F.G) {
        int lo = 0, hi_ = 1024;
        while (hi_ - lo > 1) { const int mid = (lo + hi_) >> 1; if ((int)pre[mid] <= c) lo = mid; else hi_ = mid; }
        const int pidx = lo, bh = pidx >> 6, n = pidx & 63, b = bh >> 3, h = bh & 7, cc = c - (int)pre[pidx]; const int count = (int)cl[pidx];
        {   const bf16_t* krow = BK + ((size_t)b * S + 256 * n + 32 * w + (lane & 31)) * 512 + h * 64;
            const bf16_t* vrow = BV + ((size_t)b * S + 256 * n + 32 * w + (lane >> 2)) * 512 + h * 64;
#pragma unroll
            for (int sub = 0; sub < 4; ++sub) { dma_k_piece(krow, lane, ldsK + w * 4096, sub); dma_v_piece(vrow + (size_t)(16 * (sub & 1)) * 512, lane, ldsV + w * 4096, sub); } }
        const int ei = 256 * cc + 32 * w + r32; const bool valid = ei < count;
        const unsigned e = valid ? (unsigned)list[(size_t)pidx * 16384 + ei] : (unsigned)(256 * (n + 1));
        const int t = (int)(e & 0x3fffu), j = (int)(e >> 14);
        const size_t m = (size_t)b * S + t;
        bf16x8 qr[4];
#pragma unroll
        for (int d0 = 0; d0 < 4; ++d0) qr[d0] = *(const bf16x8*)(BQ + m * 512 + h * 64 + d0 * 16 + hi * 8);
        const float cs = __builtin_amdgcn_exp2f(-(float)(h + 1)) * LOG2E;
        float ck[16];
#pragma unroll
        for (int r = 0; r < 16; ++r) ck[r] = cs * (float)crow(r, hi);
        const float cq0 = -cs * (float)(t - 256 * n), ctile = 32.f * cs;
        asm volatile("s_waitcnt vmcnt(0)" ::: "memory"); __syncthreads();
        float m_run = NEGBIG, l_run = 0.f; f32x16 o0, o1;
#pragma unroll
        for (int r = 0; r < 16; ++r) { o0[r] = 0.f; o1[r] = 0.f; }
#pragma unroll 1
        for (int c2 = 0; c2 < 2; ++c2)
            attn_chunk<4, false, false>(qr, ldsK + c2 * 16384 + hi * 512 + r32 * 16, ldsV + c2 * 16384 + v_lanepart(lane), ck, cq0 + (float)(4 * c2) * ctile, ctile, 0, r32, hi, m_run, l_run, o0, o1);
        const float l = l_run + __shfl_xor(l_run, 32), inv = __builtin_amdgcn_rcpf(l);
        if (valid) {
            bf16_t* po = (bf16_t*)(R1 + (size_t)(6 + j) * SLOT) + m * 512 + h * 64 + 4 * hi;
#pragma unroll
            for (int gg = 0; gg < 4; ++gg) {
                u32x2 a; a.x = cvtpk(o0[4 * gg] * inv, o0[4 * gg + 1] * inv); a.y = cvtpk(o0[4 * gg + 2] * inv, o0[4 * gg + 3] * inv);
                u32x2 cc2; cc2.x = cvtpk(o1[4 * gg] * inv, o1[4 * gg + 1] * inv); cc2.y = cvtpk(o1[4 * gg + 2] * inv, o1[4 * gg + 3] * inv);
                *(u32x2*)(po + 8 * gg) = a; *(u32x2*)(po + 32 + 8 * gg) = cc2;
            }
            if (hi == 0) PL[((size_t)j * M + m) * 8 + h] = m_run + __builtin_amdgcn_logf(l);
        }
        __syncthreads();
    }
}
DI void moba_own_phase(Frame& F) {
    int lane_ = F.lane; asm volatile("" : "+v"(lane_)); const int lane = lane_, r32 = lane & 31, hi = lane >> 5, w = F.wave;
    LAS unsigned char* ldsK = F.lds; LAS unsigned char* ldsV = F.lds + 32768;
    const bf16_t* BQ = (const bf16_t*)(F.dout); const bf16_t* BK = (const bf16_t*)(F.dout + 1 * SLOT); const bf16_t* BV = (const bf16_t*)(F.dout + 2 * SLOT); bf16_t* BG = (bf16_t*)(F.dout + 3 * SLOT);
    unsigned char* R1 = F.ws + WS_R1; const float* PL = (const float*)(F.ws + WS_PL);
    for (int u = F.vcu; u < 1024; u += F.G) {
        const int bh = u >> 6, qb = u & 63, b = bh >> 3, h = bh & 7;
        {   const bf16_t* krow = BK + ((size_t)b * S + 256 * qb + 32 * w + (lane & 31)) * 512 + h * 64;
            const bf16_t* vrow = BV + ((size_t)b * S + 256 * qb + 32 * w + (lane >> 2)) * 512 + h * 64;
#pragma unroll
            for (int sub = 0; sub < 4; ++sub) { dma_k_piece(krow, lane, ldsK + w * 4096, sub); dma_v_piece(vrow + (size_t)(16 * (sub & 1)) * 512, lane, ldsV + w * 4096, sub); } }
        const size_t m = (size_t)b * S + 256 * qb + 32 * w + r32;
        bf16x8 qr[4];
#pragma unroll
        for (int d0 = 0; d0 < 4; ++d0) qr[d0] = *(const bf16x8*)(BQ + m * 512 + h * 64 + d0 * 16 + hi * 8);
        const float cs = __builtin_amdgcn_exp2f(-(float)(h + 1)) * LOG2E;
        float ck[16];
#pragma unroll
        for (int r = 0; r < 16; ++r) ck[r] = cs * (float)crow(r, hi);
        const float cq0 = -cs * (float)(32 * w + r32), ctile = 32.f * cs;
        asm volatile("s_waitcnt vmcnt(0)" ::: "memory"); __syncthreads();
        float m_run = NEGBIG, l_run = 0.f; f32x16 o0, o1;
#pragma unroll
        for (int r = 0; r < 16; ++r) { o0[r] = 0.f; o1[r] = 0.f; }
        LAS const unsigned char* kp = ldsK + hi * 512 + r32 * 16; LAS const unsigned char* vp = ldsV + v_lanepart(lane);
        int bt = 0;
        if (w >= 4) { attn_chunk<4, false, false>(qr, kp, vp, ck, cq0, ctile, 0, r32, hi, m_run, l_run, o0, o1); bt = 4; }
        const int nrem = w - bt + 1; const float cq1 = cq0 + (float)bt * ctile;
        if (nrem == 1) attn_chunk<1, false, true>(qr, kp + bt * 4096, vp + bt * 4096, ck, cq1, ctile, 0, r32, hi, m_run, l_run, o0, o1);
        else if (nrem == 2) attn_chunk<2, false, true>(qr, kp + bt * 4096, vp + bt * 4096, ck, cq1, ctile, 0, r32, hi, m_run, l_run, o0, o1);
        else if (nrem == 3) attn_chunk<3, false, true>(qr, kp + bt * 4096, vp + bt * 4096, ck, cq1, ctile, 0, r32, hi, m_run, l_run, o0, o1);
        else attn_chunk<4, false, true>(qr, kp + bt * 4096, vp + bt * 4096, ck, cq1, ctile, 0, r32, hi, m_run, l_run, o0, o1);
        const float l = l_run + __shfl_xor(l_run, 32), Lown = m_run + __builtin_amdgcn_logf(l);
        const int nsel = qb < 3 ? qb : 3;
        const float L0 = nsel > 0 ? PL[((size_t)0 * M + m) * 8 + h] : NEGBIG, L1 = nsel > 1 ? PL[((size_t)1 * M + m) * 8 + h] : NEGBIG, L2 = nsel > 2 ? PL[((size_t)2 * M + m) * 8 + h] : NEGBIG;
        const float Lmax = fmaxf(fmaxf(Lown, L0), fmaxf(L1, L2));
        const float eo = __builtin_amdgcn_exp2f(Lown - Lmax), w0 = nsel > 0 ? __builtin_amdgcn_exp2f(L0 - Lmax) : 0.f, w1 = nsel > 1 ? __builtin_amdgcn_exp2f(L1 - Lmax) : 0.f, w2 = nsel > 2 ? __builtin_amdgcn_exp2f(L2 - Lmax) : 0.f;
        const float rden = __builtin_amdgcn_rcpf(eo + w0 + w1 + w2), wo = eo * __builtin_amdgcn_rcpf(l) * rden, x0 = w0 * rden, x1 = w1 * rden, x2 = w2 * rden;
        const size_t off = m * 512 + h * 64 + 4 * hi;
        const bf16_t* P0 = (const bf16_t*)(R1 + 6 * SLOT) + off; const bf16_t* P1 = (const bf16_t*)(R1 + 7 * SLOT) + off; const bf16_t* P2 = (const bf16_t*)(R1 + 8 * SLOT) + off;
#pragma unroll
        for (int hd = 0; hd < 2; ++hd)
#pragma unroll
            for (int gg = 0; gg < 4; ++gg) {
                const int co = 32 * hd + 8 * gg;
                float v[4];
#pragma unroll
                for (int jj = 0; jj < 4; ++jj) v[jj] = (hd == 0 ? o0[4 * gg + jj] : o1[4 * gg + jj]) * wo;
                if (nsel > 0) { const u32x2 p = *(const u32x2*)(P0 + co); v[0] += x0 * bf_lo(p.x); v[1] += x0 * bf_hi(p.x); v[2] += x0 * bf_lo(p.y); v[3] += x0 * bf_hi(p.y); }
                if (nsel > 1) { const u32x2 p = *(const u32x2*)(P1 + co); v[0] += x1 * bf_lo(p.x); v[1] += x1 * bf_hi(p.x); v[2] += x1 * bf_lo(p.y); v[3] += x1 * bf_hi(p.y); }
                if (nsel > 2) { const u32x2 p = *(const u32x2*)(P2 + co); v[0] += x2 * bf_lo(p.x); v[1] += x2 * bf_hi(p.x); v[2] += x2 * bf_lo(p.y); v[3] += x2 * bf_hi(p.y); }
                const u32x2 g = *(const u32x2*)(BG + off + co);
                u32x2 r; r.x = cvtpk(v[0] * bf_lo(g.x), v[1] * bf_hi(g.x)); r.y = cvtpk(v[2] * bf_lo(g.y), v[3] * bf_hi(g.y));
                *(u32x2*)(BG + off + co) = r;
            }
        __syncthreads();
    }
}

DI void combineA_phase(Frame& F) {
    unsigned char* R1 = F.ws + WS_R1; const float* LSEA = (const float*)(F.ws + WS_LSEA);
    bf16_t* AG = (bf16_t*)(R1 + (size_t)SLOT_AG * SLOT);
    for (int idx = F.vcu * 512 + F.tid; idx < M * 64; idx += F.G * 512) {
        const int c8 = idx & 7, h = (idx >> 3) & 7, m = idx >> 6;
        const float L0 = LSEA[((size_t)0 * M + m) * 8 + h], L1 = LSEA[((size_t)1 * M + m) * 8 + h], L2 = LSEA[((size_t)2 * M + m) * 8 + h];
        const float mx = fmaxf(L0, fmaxf(L1, L2));
        float w0 = __builtin_amdgcn_exp2f(L0 - mx), w1 = __builtin_amdgcn_exp2f(L1 - mx), w2 = __builtin_amdgcn_exp2f(L2 - mx);
        const float inv = __builtin_amdgcn_rcpf(w0 + w1 + w2); w0 *= inv; w1 *= inv; w2 *= inv;
        const size_t off = (size_t)m * 512 + h * 64 + c8 * 8;
        const u32x4 a = *(const u32x4*)((const bf16_t*)(R1 + 0 * SLOT) + off), bq = *(const u32x4*)((const bf16_t*)(R1 + 1 * SLOT) + off), c = *(const u32x4*)((const bf16_t*)(R1 + 2 * SLOT) + off);
        const u32x4 gt = *(const u32x4*)(AG + off);
        u32x4 o;
#define CMB(f) o.f = pk2((w0 * bf_lo(a.f) + w1 * bf_lo(bq.f) + w2 * bf_lo(c.f)) * bf_lo(gt.f), (w0 * bf_hi(a.f) + w1 * bf_hi(bq.f) + w2 * bf_hi(c.f)) * bf_hi(gt.f))
        CMB(x); CMB(y); CMB(z); CMB(w);
#undef CMB
        *(u32x4*)(AG + off) = o;
    }
}

__device__ __forceinline__ void load64(const bf16_t* p, float* f) {
#pragma unroll
    for (int c = 0; c < 8; ++c) { const u32x4 w = *(const u32x4*)(p + 8 * c);
        f[8 * c + 0] = __uint_as_float(w.x << 16); f[8 * c + 1] = __uint_as_float(w.x & 0xffff0000u);
        f[8 * c + 2] = __uint_as_float(w.y << 16); f[8 * c + 3] = __uint_as_float(w.y & 0xffff0000u);
        f[8 * c + 4] = __uint_as_float(w.z << 16); f[8 * c + 5] = __uint_as_float(w.z & 0xffff0000u);
        f[8 * c + 6] = __uint_as_float(w.w << 16); f[8 * c + 7] = __uint_as_float(w.w & 0xffff0000u); }
}
#define ATT_STEP(krow, vrow, bias2) do { \
    float kk_[64]; load64((krow), kk_); float s_ = 0.f; \
    _Pragma("unroll") for (int d_ = 0; d_ < 64; ++d_) s_ += q[d_] * kk_[d_]; \
    s_ += (bias2); \
    const float mn_ = fmaxf(mrun, s_), f_ = exp2f(mrun - mn_), p_ = exp2f(s_ - mn_); \
    float vv_[64]; load64((vrow), vv_); \
    lrun = lrun * f_ + p_; mrun = mn_; \
    _Pragma("unroll") for (int d_ = 0; d_ < 64; ++d_) o[d_] = o[d_] * f_ + p_ * vv_[d_]; } while (0)
__device__ __forceinline__ void store_gated(bf16_t* gp, const float* o, float inv) {
#pragma unroll
    for (int c = 0; c < 8; ++c) { const u32x4 w = *(const u32x4*)(gp + 8 * c); u32x4 r;
        r.x = pk2(o[8 * c + 0] * inv * __uint_as_float(w.x << 16), o[8 * c + 1] * inv * __uint_as_float(w.x & 0xffff0000u));
        r.y = pk2(o[8 * c + 2] * inv * __uint_as_float(w.y << 16), o[8 * c + 3] * inv * __uint_as_float(w.y & 0xffff0000u));
        r.z = pk2(o[8 * c + 4] * inv * __uint_as_float(w.z << 16), o[8 * c + 5] * inv * __uint_as_float(w.z & 0xffff0000u));
        r.w = pk2(o[8 * c + 6] * inv * __uint_as_float(w.w << 16), o[8 * c + 7] * inv * __uint_as_float(w.w & 0xffff0000u));
        *(u32x4*)(gp + 8 * c) = r; }
}
__device__ __forceinline__ void gold_mixA(Frame& F) {
    unsigned char* R1 = F.ws + WS_R1;
    for (int idx = F.vcu * 512 + F.tid; idx < M * 8; idx += F.G * 512) {
        const int h = idx & 7, m = idx >> 3, b = m / S, t = m % S;
        const float slope2 = exp2f(-(float)h - 0.5f) * LOG2E;
        float o[64]; float mrun = -1e30f, lrun = 0.f;
#pragma unroll
        for (int d = 0; d < 64; ++d) o[d] = 0.f;
        for (int g = 0; g < 3; ++g) {
            const int dil = (g == 0) ? 1 : (g == 1) ? 4 : 16;
            const bf16_t* Q = (const bf16_t*)(R1 + (size_t)slot_q(g) * SLOT);
            const bf16_t* Kp = (const bf16_t*)(R1 + (size_t)slot_k(g) * SLOT);
            const bf16_t* Vp = (const bf16_t*)(R1 + (size_t)slot_v(g) * SLOT);
            float q[64]; load64(Q + (size_t)m * 512 + h * 64, q);
            for (int j = 0; j <= 128; ++j) {
                const int tk = t - j * dil; if (tk < 0) break;
                const size_t kr = ((size_t)b * S + tk) * 512 + h * 64;
                ATT_STEP(Kp + kr, Vp + kr, -slope2 * (float)(j * dil));
            }
        }
        bf16_t* AG = (bf16_t*)(R1 + (size_t)SLOT_AG * SLOT);
        store_gated(AG + (size_t)m * 512 + h * 64, o, 1.f / lrun);
    }
}
__device__ __forceinline__ void gold_kmean(Frame& F) {
    const bf16_t* BK = (const bf16_t*)(F.dout + 1 * SLOT); float* kmean = (float*)(F.ws + WS_KMEAN);
    for (int idx = F.vcu * 512 + F.tid; idx < 16 * 64 * 64; idx += F.G * 512) {
        const int d = idx & 63, n = (idx >> 6) & 63, bh = idx >> 12, b = bh >> 3, h = bh & 7;
        float s = 0.f;
        for (int r = 0; r < 256; ++r) s += bf2f(BK[((size_t)b * S + n * 256 + r) * 512 + h * 64 + d]);
        kmean[idx] = s * (1.f / 256.f);
    }
}
__device__ __forceinline__ void gold_moba(Frame& F) {
    const bf16_t* BQ = (const bf16_t*)(F.dout); const bf16_t* BK = (const bf16_t*)(F.dout + 1 * SLOT); const bf16_t* BV = (const bf16_t*)(F.dout + 2 * SLOT);
    bf16_t* BG = (bf16_t*)(F.dout + 3 * SLOT); const float* kmean = (const float*)(F.ws + WS_KMEAN);
    for (int idx = F.vcu * 512 + F.tid; idx < M * 8; idx += F.G * 512) {
        const int h = idx & 7, m = idx >> 3, b = m / S, t = m % S, qb = t >> 8;
        const float slope2 = exp2f(-(float)(h + 1)) * LOG2E;
        float q[64]; load64(BQ + (size_t)m * 512 + h * 64, q);
        float bv0 = -INFINITY, bv1 = -INFINITY, bv2 = -INFINITY; int bi0 = -1, bi1 = -1, bi2 = -1;
        const float* km = kmean + (size_t)(b * 8 + h) * 64 * 64;
        for (int n = 0; n < qb; ++n) {
            float s = 0.f;
#pragma unroll
            for (int d = 0; d < 64; ++d) s += q[d] * km[n * 64 + d];
            if (s > bv0) { bv2 = bv1; bi2 = bi1; bv1 = bv0; bi1 = bi0; bv0 = s; bi0 = n; }
            else if (s > bv1) { bv2 = bv1; bi2 = bi1; bv1 = s; bi1 = n; }
            else if (s > bv2) { bv2 = s; bi2 = n; }
        }
        float o[64]; float mrun = -1e30f, lrun = 0.f;
#pragma unroll
        for (int d = 0; d < 64; ++d) o[d] = 0.f;
        for (int j = 0; j < 4; ++j) {
            const int blk = (j == 0) ? bi0 : (j == 1) ? bi1 : (j == 2) ? bi2 : qb;
            if (blk < 0) continue;
            const int p0 = blk * 256;
            for (int kk = 0; kk < 256; ++kk) {
                const int pos = p0 + kk; if (pos > t) break;
                const size_t kr = ((size_t)b * S + pos) * 512 + h * 64;
                ATT_STEP(BK + kr, BV + kr, -slope2 * (float)(t - pos));
            }
        }
        store_gated(BG + (size_t)m * 512 + h * 64, o, 1.f / lrun);
    }
}
__device__ __forceinline__ void gold_mem(Frame& F) {
    const bf16_t* MQ = (const bf16_t*)(F.ws + WS_MQ); bf16_t* MG = (bf16_t*)(F.ws + WS_MG);
    const bf16_t* KM = (const bf16_t*)(F.ws + WS_KM); const bf16_t* VM = (const bf16_t*)(F.ws + WS_VM);
    for (int idx = F.vcu * 512 + F.tid; idx < M * 4; idx += F.G * 512) {
        const int h = idx & 3, m = idx >> 2, b = m / S;
        float q[64]; load64(MQ + (size_t)m * 256 + h * 64, q);
        float o[64]; float mrun = -1e30f, lrun = 0.f;
#pragma unroll
        for (int d = 0; d < 64; ++d) o[d] = 0.f;
        for (int j = 0; j < 256; ++j) {
            const size_t kr = ((size_t)b * 256 + j) * 256 + h * 64;
            ATT_STEP(KM + kr, VM + kr, 0.f);
        }
        store_gated(MG + (size_t)m * 256 + h * 64, o, 1.f / lrun);
    }
}
__device__ __forceinline__ void final_norm_rows(Frame& F) {
    const int gw = F.vcu * NWAVES + F.wave, NGW = F.G * NWAVES; float* out = (float*)F.dout;
    for (int row = gw; row < M; row += NGW) {
        GAS f32x4* xr = (GAS f32x4*)(out + (size_t)row * D) + F.lane;
        f32x4 v[4]; float s = 0.f;
#pragma unroll
        for (int j = 0; j < 4; ++j) { v[j] = xr[64 * j]; s += (v[j].x * v[j].x + v[j].y * v[j].y) + (v[j].z * v[j].z + v[j].w * v[j].w); }
        const float rs = 1.0f / sqrtf(wave_sum(s) * (1.f / D) + EPS);
#pragma unroll
        for (int j = 0; j < 4; ++j) { const f32x4 ww = ((const GAS f32x4*)F.final_w)[F.lane + 64 * j]; xr[64 * j] = (f32x4){v[j].x * rs * ww.x, v[j].y * rs * ww.y, v[j].z * rs * ww.z, v[j].w * rs * ww.w}; }
    }
}

struct Args { const float* in[12]; float* out; unsigned char* ws; };
__global__ void __launch_bounds__(NWAVES * 64, 2) mk_fwd(Args args) {
    extern __shared__ __attribute__((aligned(16))) unsigned char lds[];
    Frame F;
    F.lds = (LAS unsigned char*)lds; F.MISC = (volatile LAS unsigned*)(F.lds + MISC_OFF);
    F.tid = threadIdx.x; F.lane = F.tid & 63; F.wave = __builtin_amdgcn_readfirstlane(F.tid >> 6);
    F.G = gridDim.x; { const int bx = blockIdx.x; F.vcu = (F.G % 8 == 0) ? (bx % 8) * (F.G / 8) + bx / 8 : bx; }
    F.ws = args.ws; F.dout = (unsigned char*)args.out;
    F.x = args.in[0]; F.mem = args.in[1]; F.norm_w = args.in[2]; F.mem_norm_w = args.in[3]; F.w_in = args.in[4]; F.b_merge = args.in[5]; F.w_mem_kv = args.in[6];
    F.w_a = args.in[7]; F.w_b = args.in[8]; F.w_m = args.in[9]; F.w_out = args.in[10]; F.final_w = args.in[11];
    for (int u = F.tid; u < (LDS_BYTES - LDSCTL_OFF) / 4; u += NWAVES * 64) ((LAS unsigned*)(F.lds + LDSCTL_OFF))[u] = 0u;
    __syncthreads();
    XcdBarrier bar = xcd_barrier_post((unsigned*)(F.ws + WS_CTL) + CW_BAR, F.MISC + 8);
#define GRID_BAR() xcd_barrier(bar)
    bf16_t* WIN = (bf16_t*)(F.ws + WS_WIN); bf16_t* XN = (bf16_t*)(F.ws + WS_XN);

    p0_prologue(F); GRID_BAR();
    { pg8::Gemm g{XN, WIN, M, 30 * 256, 1024}; pg8::StaticOrder So; So.init(M, 30 * 256, F.G, (int)blockIdx.x);
      pg8::EpiProj E{F.ws, F.dout, F.b_merge, 0};
      pg8::gemm_phase<pg8::EpiProj, pg8::StaticOrder, true, true>(F.lds + RING_OFF, g, So, E); }
    GRID_BAR();
    mixA_phase(F); kmean_phase(F); memattn_phase(F); GRID_BAR();
    select_phase(F); combineA_phase(F); GRID_BAR();
    moba_sel_phase(F); GRID_BAR();
    moba_own_phase(F);
    { pg8::Gemm g{XN, WIN + (size_t)30 * 256 * 1024, M, 12 * 256, 1024}; pg8::StaticOrder So; So.init(M, 12 * 256, F.G, (int)blockIdx.x);
      pg8::EpiProj E{F.ws, F.dout, F.b_merge, 30};
      pg8::gemm_phase<pg8::EpiProj, pg8::StaticOrder, true, true>(F.lds + RING_OFF, g, So, E); }
    GRID_BAR();
    { bf16_t* MRG = XN; pg8::StaticOrder So; So.init(M, 1024, F.G, (int)blockIdx.x);
      { pg8::Gemm g{(const bf16_t*)(F.ws + WS_R1 + (size_t)SLOT_AG * SLOT), (const bf16_t*)(F.ws + WS_WA), M, 1024, 512};
        pg8::EpiMerge E{MRG, (const bf16_t*)(F.ws + WS_R1 + 0 * SLOT), 1}; pg8::gemm_phase<pg8::EpiMerge, pg8::StaticOrder, true, true>(F.lds + RING_OFF, g, So, E); }
      { pg8::Gemm g{(const bf16_t*)(F.dout + 3 * SLOT), (const bf16_t*)(F.ws + WS_WB), M, 1024, 512};
        pg8::EpiMerge E{MRG, (const bf16_t*)(F.ws + WS_R1 + 2 * SLOT), 0}; pg8::gemm_phase<pg8::EpiMerge, pg8::StaticOrder, true, true>(F.lds + RING_OFF, g, So, E); }
      { pg8::Gemm g{(const bf16_t*)(F.ws + WS_MG), (const bf16_t*)(F.ws + WS_WM), M, 1024, 256};
        pg8::EpiMerge E{MRG, (const bf16_t*)(F.ws + WS_R1 + 4 * SLOT), 0}; pg8::gemm_phase<pg8::EpiMerge, pg8::StaticOrder, true, true>(F.lds + RING_OFF, g, So, E); } }
    GRID_BAR();
    { pg8::Gemm g{XN, (const bf16_t*)(F.ws + WS_WO), M, 1024, 1024}; pg8::StaticOrder So; So.init(M, 1024, F.G, (int)blockIdx.x);
      pg8::EpiOut E{F.x, (float*)F.dout}; pg8::gemm_phase<pg8::EpiOut, pg8::StaticOrder, true, true>(F.lds + RING_OFF, g, So, E); }
    GRID_BAR();
    final_norm_rows(F);
}

extern "C" void kernel_launch(void* const* d_in, const int* in_sizes, int n_in, void* d_out, int out_size, void* d_ws, size_t ws_size, hipStream_t stream) {
    static int grid = 0;
    if (grid == 0) {
        if (n_in != 12 || out_size != M * D || ws_size < WS_END) { fprintf(stderr, "kernel_launch: unexpected sizes (n_in %d out %d ws %zu)\n", n_in, out_size, ws_size); grid = -1; return; }
        int dev = 0, cus = 0, per_cu = 0;
        if (hipGetDevice(&dev) != hipSuccess || hipDeviceGetAttribute(&cus, hipDeviceAttributeMultiprocessorCount, dev) != hipSuccess) { grid = -1; return; }
        if (hipFuncSetAttribute((const void*)mk_fwd, hipFuncAttributeMaxDynamicSharedMemorySize, LDS_BYTES) != hipSuccess) { fprintf(stderr, "kernel_launch: hipFuncSetAttribute failed\n"); grid = -1; return; }
        if (hipOccupancyMaxActiveBlocksPerMultiprocessor(&per_cu, (const void*)mk_fwd, NWAVES * 64, LDS_BYTES) != hipSuccess || per_cu < 1) { fprintf(stderr, "kernel_launch: occupancy query says %d blocks/CU\n", per_cu); (void)hipGetLastError(); grid = -1; return; }
        grid = cus;
    }
    if (grid < 0) return;
    if (hipMemsetAsync((char*)d_ws + WS_CTL, 0, CTL_ZERO_BYTES, stream) != hipSuccess) return;
    Args a{};
    for (int i = 0; i < 12; ++i) a.in[i] = (const float*)d_in[i];
    a.out = (float*)d_out; a.ws = (unsigned char*)d_ws;
    void* kargs[] = {&a};
    hipError_t e = hipLaunchCooperativeKernel((const void*)mk_fwd, dim3(grid), dim3(NWAVES * 64), kargs, LDS_BYTES, stream);
    if (e != hipSuccess) fprintf(stderr, "kernel_launch: cooperative launch failed: %s (grid %d)\n", hipGetErrorString(e), grid);
}
```
